# Optimizing an MI355X kernel written in HIP

```python
import math
import jax, jax.numpy as jnp
from jax import lax
import numpy as np

D_MODEL = 2048
BATCH = 2
SEQ = 8192
DEPTH = 4

HEAD_DIM = 128
ATTN_Q_HEADS = 12
ATTN_KV_HEADS = 4
ATTN_GROUP = ATTN_Q_HEADS // ATTN_KV_HEADS
WINDOW = 128
ATTN_BLOCK = 128
RET_HEADS = 6
RET_DK = 128
RET_DV = 256
RET_CHUNK = 128
CROSS_HEADS = 4
MEM_LEN = 256
N_EXPERTS = 16
EXPERT_FF = 1024
CAPACITY_FACTOR = 2
NORM_EPS = 1e-6
NEG_INF = -1e30
N_ATTN_LAYERS = (DEPTH + 1) // 2
N_RET_LAYERS = DEPTH // 2

ATTN_Q_W = ATTN_Q_HEADS * HEAD_DIM
ATTN_KV_W = ATTN_KV_HEADS * HEAD_DIM
CROSS_W = CROSS_HEADS * HEAD_DIM
ATTN_IN_W = ATTN_Q_W + 2 * ATTN_KV_W + CROSS_W
RET_QK_W = RET_HEADS * RET_DK
RET_V_W = RET_HEADS * RET_DV
RET_IN_W = 2 * RET_QK_W + 2 * RET_V_W + CROSS_W

kernel_name = "hybrid_window_gqa_retention_ec_moe"


def rms_norm(x, gain):
    xf = x.astype(jnp.float32)
    y = xf * lax.rsqrt(jnp.mean(xf * xf, axis=-1, keepdims=True) + NORM_EPS)
    return (y * gain.astype(jnp.float32)).astype(x.dtype)


def alibi_slopes(n):
    def pow2_slopes(m):
        start = 2.0 ** (-(2.0 ** -(math.log2(m) - 3)))
        return [start ** (i + 1) for i in range(m)]
    if math.log2(n).is_integer():
        return pow2_slopes(n)
    closest = 2 ** math.floor(math.log2(n))
    return pow2_slopes(closest) + alibi_slopes(2 * closest)[0::2][: n - closest]


def windowed_gqa(q, k, v, sink):
    bsz, seq, _, d = q.shape
    nb = seq // ATTN_BLOCK
    c = ATTN_BLOCK
    qb = q.reshape(bsz, nb, c, ATTN_KV_HEADS, ATTN_GROUP, d)

    def band(t):
        tb = t.reshape(bsz, nb, c, ATTN_KV_HEADS, d)
        pad = jnp.pad(tb, ((0, 0), (1, 1), (0, 0), (0, 0), (0, 0)))
        return jnp.concatenate([pad[:, :-2], pad[:, 1:-1], pad[:, 2:]], axis=2)

    kb, vb = band(k), band(v)
    s = jnp.einsum('bnqhgd,bnshd->bhgnqs', qb, kb).astype(jnp.float32) * (d ** -0.5)
    qi = jnp.arange(c)[:, None]
    sj = jnp.arange(3 * c)[None, :]
    dist = jnp.abs(qi + c - sj)
    key_pos = jnp.arange(nb)[:, None] * c - c + jnp.arange(3 * c)[None, :]
    valid = (dist <= WINDOW)[None] & ((key_pos >= 0) & (key_pos < seq))[:, None, :]
    slopes = jnp.asarray(np.array(alibi_slopes(ATTN_Q_HEADS), np.float32)).reshape(ATTN_KV_HEADS, ATTN_GROUP)
    bias = -slopes[:, :, None, None, None] * dist.astype(jnp.float32)[None, None, None]
    logits = jnp.where(valid, s + bias, NEG_INF)
    sink_r = sink.astype(jnp.float32).reshape(ATTN_KV_HEADS, ATTN_GROUP)[None, :, :, None, None, None]
    m = jnp.maximum(jnp.max(logits, axis=-1, keepdims=True), sink_r)
    p = jnp.exp(logits - m)
    p = p / (jnp.sum(p, axis=-1, keepdims=True) + jnp.exp(sink_r - m))
    o = jnp.einsum('bhgnqs,bnshd->bnqhgd', p.astype(v.dtype), vb)
    return o.reshape(bsz, seq, ATTN_Q_HEADS * d)


def retention_chunkwise(q, k, v, log_gamma, include_diag):
    bsz, seq, heads, dk = q.shape
    dv = v.shape[-1]
    nc = seq // RET_CHUNK
    q = q.reshape(bsz, nc, RET_CHUNK, heads, dk)
    k = k.reshape(bsz, nc, RET_CHUNK, heads, dk)
    v = v.reshape(bsz, nc, RET_CHUNK, heads, dv)
    pos = jnp.arange(RET_CHUNK, dtype=jnp.float32)
    delta = pos[:, None] - pos[None, :]
    mask = (delta >= 0) if include_diag else (delta > 0)
    decay = jnp.where(mask[None], jnp.exp(log_gamma[:, None, None] * jnp.maximum(delta, 0.0)[None]), 0.0)
    scores = jnp.einsum('bnthd,bnshd->bnhts', q, k) * decay
    intra = jnp.einsum('bnhts,bnshe->bnthe', scores, v)
    zeta = jnp.exp(log_gamma[:, None] * (RET_CHUNK - 1.0 - pos)[None])
    chunk_kv = jnp.einsum('bnshd,hs,bnshe->bnhde', k, zeta, v)
    chunk_decay = jnp.exp(log_gamma * RET_CHUNK)[None, :, None, None]

    def step(state, kv_n):
        return chunk_decay * state + kv_n, state

    init = jnp.zeros((bsz, heads, dk, dv), jnp.float32)
    _, prev = lax.scan(step, init, jnp.moveaxis(chunk_kv, 1, 0))
    prev = jnp.moveaxis(prev, 0, 1)
    xi = jnp.exp(log_gamma[:, None] * (pos + 1.0)[None])
    inter = jnp.einsum('bnthd,ht,bnhde->bnthe', q, xi, prev)
    return (intra + inter).reshape(bsz, seq, heads, dv)


def bidirectional_retention(q, k, v, g, decay_fwd, decay_bwd, out_gain):
    bsz, seq, _ = q.shape
    qf = q.astype(jnp.float32).reshape(bsz, seq, RET_HEADS, RET_DK)
    kf = k.astype(jnp.float32).reshape(bsz, seq, RET_HEADS, RET_DK) * (RET_DK ** -0.5)
    vf = v.astype(jnp.float32).reshape(bsz, seq, RET_HEADS, RET_DV)
    lg_f = jax.nn.log_sigmoid(decay_fwd.astype(jnp.float32))
    lg_b = jax.nn.log_sigmoid(decay_bwd.astype(jnp.float32))
    fwd = retention_chunkwise(qf, kf, vf, lg_f, True)
    bwd = retention_chunkwise(qf[:, ::-1], kf[:, ::-1], vf[:, ::-1], lg_b, False)[:, ::-1]
    y = rms_norm(fwd + bwd, out_gain.reshape(RET_HEADS, RET_DV)).reshape(bsz, seq, RET_V_W)
    return (jax.nn.silu(g.astype(jnp.float32)) * y).astype(g.dtype)


def memory_cross_attention(qc, kc, vc):
    bsz, seq, _, d = qc.shape
    s = jnp.einsum('bshd,bmhd->bhsm', qc, kc).astype(jnp.float32) * (d ** -0.5)
    p = jax.nn.softmax(s, axis=-1).astype(vc.dtype)
    o = jnp.einsum('bhsm,bmhd->bshd', p, vc)
    return o.reshape(bsz, seq, CROSS_W)


def expert_choice_moe(h, w_router, w_gate, w_up, w_down):
    bsz, seq, d = h.shape
    cap = CAPACITY_FACTOR * seq // N_EXPERTS
    affinity = jax.nn.softmax((h @ w_router).astype(jnp.float32), axis=-1)
    gates, idx = lax.top_k(jnp.swapaxes(affinity, 1, 2), cap)
    xin = jax.vmap(lambda hb, ib: hb[ib])(h, idx)
    hid = jax.nn.silu(jnp.einsum('becd,edf->becf', xin, w_gate)) * jnp.einsum('becd,edf->becf', xin, w_up)
    y = jnp.einsum('becf,efd->becd', hid, w_down) * gates[..., None].astype(h.dtype)
    flat = (idx + (jnp.arange(bsz) * seq)[:, None, None]).reshape(-1)
    out = jnp.zeros((bsz * seq, d), h.dtype).at[flat].add(y.reshape(-1, d))
    return out.reshape(bsz, seq, d)


def setup_inputs(seed: int = 0) -> dict:
    key = jax.random.key(seed)
    ks = jax.random.split(key, 21)
    f32 = jnp.float32

    def nrm(k, shape, fan_in):
        return jax.random.normal(k, shape, f32) * (fan_in ** -0.5)

    def gain(k, shape):
        return 1.0 + 0.02 * jax.random.normal(k, shape, f32)

    decay_base = jnp.log(2.0 ** (5.0 + jnp.arange(RET_HEADS, dtype=f32)) - 1.0)
    return {
        "x": jax.random.normal(ks[0], (BATCH, SEQ, D_MODEL), f32),
        "mem": jax.random.normal(ks[1], (BATCH, MEM_LEN, D_MODEL), f32),
        "norm1_gain": gain(ks[2], (DEPTH, D_MODEL)),
        "w_in_attn": nrm(ks[3], (N_ATTN_LAYERS, D_MODEL, ATTN_IN_W), D_MODEL),
        "attn_q_gain": gain(ks[4], (N_ATTN_LAYERS, HEAD_DIM)),
        "attn_k_gain": gain(ks[5], (N_ATTN_LAYERS, HEAD_DIM)),
        "attn_sink": jax.random.normal(ks[6], (N_ATTN_LAYERS, ATTN_Q_HEADS), f32),
        "w_in_ret": nrm(ks[7], (N_RET_LAYERS, D_MODEL, RET_IN_W), D_MODEL),
        "ret_decay_fwd": decay_base[None] + 0.1 * jax.random.normal(ks[8], (N_RET_LAYERS, RET_HEADS), f32),
        "ret_decay_bwd": decay_base[None] + 0.1 * jax.random.normal(ks[9], (N_RET_LAYERS, RET_HEADS), f32),
        "ret_out_gain": gain(ks[10], (N_RET_LAYERS, RET_V_W)),
        "mem_norm_gain": gain(ks[11], (DEPTH, D_MODEL)),
        "w_mem_kv": nrm(ks[12], (DEPTH, D_MODEL, 2 * CROSS_W), D_MODEL),
        "cross_q_gain": gain(ks[13], (DEPTH, HEAD_DIM)),
        "cross_k_gain": gain(ks[14], (DEPTH, HEAD_DIM)),
        "w_out": nrm(ks[15], (DEPTH, D_MODEL, D_MODEL), D_MODEL),
        "norm2_gain": gain(ks[16], (DEPTH, D_MODEL)),
        "w_router": nrm(ks[17], (DEPTH, D_MODEL, N_EXPERTS), D_MODEL),
        "w_gate": nrm(ks[18], (DEPTH, N_EXPERTS, D_MODEL, EXPERT_FF), D_MODEL),
        "w_up": nrm(ks[19], (DEPTH, N_EXPERTS, D_MODEL, EXPERT_FF), D_MODEL),
        "w_down": nrm(ks[20], (DEPTH, N_EXPERTS, EXPERT_FF, D_MODEL), EXPERT_FF),
    }


def reference(x, mem, norm1_gain, w_in_attn, attn_q_gain, attn_k_gain, attn_sink,
              w_in_ret, ret_decay_fwd, ret_decay_bwd, ret_out_gain, mem_norm_gain,
              w_mem_kv, cross_q_gain, cross_k_gain, w_out, norm2_gain, w_router,
              w_gate, w_up, w_down):
    bsz, seq, _ = x.shape
    mem_len = mem.shape[1]
    for layer in range(DEPTH):
        h = rms_norm(x, norm1_gain[layer])
        kvm = rms_norm(mem, mem_norm_gain[layer]) @ w_mem_kv[layer]
        kc, vc = jnp.split(kvm, [CROSS_W], axis=-1)
        kc = rms_norm(kc.reshape(bsz, mem_len, CROSS_HEADS, HEAD_DIM), cross_k_gain[layer])
        vc = vc.reshape(bsz, mem_len, CROSS_HEADS, HEAD_DIM)
        li = layer // 2
        if layer % 2 == 0:
            proj = h @ w_in_attn[li]
            q, k, v, qc = jnp.split(proj, [ATTN_Q_W, ATTN_Q_W + ATTN_KV_W, ATTN_Q_W + 2 * ATTN_KV_W], axis=-1)
            q = rms_norm(q.reshape(bsz, seq, ATTN_Q_HEADS, HEAD_DIM), attn_q_gain[li])
            k = rms_norm(k.reshape(bsz, seq, ATTN_KV_HEADS, HEAD_DIM), attn_k_gain[li])
            v = v.reshape(bsz, seq, ATTN_KV_HEADS, HEAD_DIM)
            mix = windowed_gqa(q, k, v, attn_sink[li])
        else:
            proj = h @ w_in_ret[li]
            q, k, v, g, qc = jnp.split(
                proj, [RET_QK_W, 2 * RET_QK_W, 2 * RET_QK_W + RET_V_W, 2 * RET_QK_W + 2 * RET_V_W], axis=-1)
            mix = bidirectional_retention(q, k, v, g, ret_decay_fwd[li], ret_decay_bwd[li], ret_out_gain[li])
        qc = rms_norm(qc.reshape(bsz, seq, CROSS_HEADS, HEAD_DIM), cross_q_gain[layer])
        cross = memory_cross_attention(qc, kc, vc)
        x = x + jnp.concatenate([mix, cross], axis=-1) @ w_out[layer]
        x = x + expert_choice_moe(rms_norm(x, norm2_gain[layer]), w_router[layer],
                                  w_gate[layer], w_up[layer], w_down[layer])
    return x
```

```cpp
#include <hip/hip_runtime.h>
#include <cstdio>
#include <cstdint>

#define LAS __attribute__((address_space(3)))
typedef unsigned short bf16_t;
typedef short bf16x8 __attribute__((ext_vector_type(8)));
typedef short s16x4 __attribute__((ext_vector_type(4)));
typedef float f32x4 __attribute__((ext_vector_type(4)));
typedef float f32x2 __attribute__((ext_vector_type(2)));
typedef unsigned u32x4 __attribute__((ext_vector_type(4)));
typedef unsigned u32x2 __attribute__((ext_vector_type(2)));

#ifndef PHMASK
#define PHMASK 0xFFFFFFFFu
#endif
#ifndef PHMASK2
#define PHMASK2 0xFFFFFFFFu
#endif
#define PH_ON(k) ((((PHMASK) >> (k)) & 1u) && (L_ < 2 || (((PHMASK2) >> (k)) & 1u)))
#ifndef DUPMASK
#define DUPMASK 0u
#endif
#define DUP_ON(k) (((DUPMASK) >> (k)) & 1u)
#ifndef MERGE_RT
#define MERGE_RT 1
#endif
#ifndef MOE_B_AUX
#define MOE_B_AUX 0
#endif
#ifndef SPLIT_CV
#define SPLIT_CV 1
#endif
#ifndef DEFER_MOE
#define DEFER_MOE 1
#endif
#ifndef NLAYERS
#define NLAYERS 4
#endif
#ifndef MK_FUSED
#define MK_FUSED 1
#endif

constexpr int NB = 2, SEQ = 8192, DM = 2048, TT = NB * SEQ, DEPTH = 4;
constexpr int NEXP = 16, FF = 1024, CAP = 1024, NSLOT = NB * NEXP * CAP;
constexpr int ATT_W = 3072, RET_W = 5120, MEML = 256;
constexpr float EPS = 1e-6f;
constexpr float LOG2E = 1.4426950408889634f;
constexpr float QSCALE2 = 0.08838834764831845f * 1.4426950408889634f;

constexpr size_t MiB = (size_t)1 << 20;
constexpr size_t WS_CTL = 0, CTL_BYTES = 1 * MiB;
constexpr size_t WS_WINA = 1 * MiB;
constexpr size_t WS_WINR = 25 * MiB;
constexpr size_t WS_WMKV = 65 * MiB;
constexpr size_t WS_WOUT = 81 * MiB;
constexpr size_t WS_WGU = 113 * MiB;
constexpr size_t WS_WDN = 625 * MiB;
constexpr size_t WS_MEMN = 881 * MiB;
constexpr size_t WS_KVM = 889 * MiB;
constexpr size_t WS_PARTM = 905 * MiB;
constexpr size_t WS_H = 906 * MiB;
constexpr size_t WS_PROJ = 970 * MiB;
constexpr size_t WS_PART = 1130 * MiB;
constexpr size_t WS_CAT = 1140 * MiB;
constexpr size_t WS_KVC = 1204 * MiB;
constexpr size_t WS_ST = 1300 * MiB;
constexpr size_t WS_HID = 1396 * MiB;
constexpr size_t WS_Y = 1460 * MiB;
constexpr size_t WS_AFF = 1588 * MiB;
constexpr size_t WS_ROWIDX = 1589 * MiB;
constexpr size_t WS_GATEV = 1589 * MiB + 256 * 1024;
constexpr size_t WS_RSLOT = 1589 * MiB + 512 * 1024;
constexpr size_t WS_RS1 = 1589 * MiB + 640 * 1024;
constexpr size_t WS_RS2 = 1589 * MiB + 704 * 1024;
constexpr size_t WS_INV = 1590 * MiB;
constexpr size_t WS_XR = 1591 * MiB;
constexpr size_t WS_END = 1655 * MiB;

constexpr int LDS_BYTES = 160 * 1024;
constexpr int LDS_MISC = LDS_BYTES - 256;

__device__ __forceinline__ float bf2f(unsigned short b) { return __uint_as_float(((unsigned)b) << 16); }
typedef __bf16 bf16x2_t __attribute__((ext_vector_type(2)));
__device__ __forceinline__ unsigned pk2(float lo, float hi) { const f32x2 v = {lo, hi}; const bf16x2_t b = __builtin_convertvector(v, bf16x2_t); return __builtin_bit_cast(unsigned, b); }
__device__ __forceinline__ float shx_f(float v, int o, int lane) { return __int_as_float(__builtin_amdgcn_ds_bpermute((lane ^ o) << 2, __float_as_int(v))); }
__device__ __forceinline__ unsigned shup_u(unsigned v, int o, int lane) { return (unsigned)__builtin_amdgcn_ds_bpermute((lane - o) << 2, (int)v); }
#define SHX(v, o) shx_f((v), (o), lane)
__device__ __forceinline__ float xadd16(float x) { const u32x2 r = __builtin_amdgcn_permlane16_swap(__float_as_uint(x), __float_as_uint(x), false, false); return __uint_as_float(r[0]) + __uint_as_float(r[1]); }
__device__ __forceinline__ float xadd32(float x) { const u32x2 r = __builtin_amdgcn_permlane32_swap(__float_as_uint(x), __float_as_uint(x), false, false); return __uint_as_float(r[0]) + __uint_as_float(r[1]); }
__device__ __forceinline__ float xmax16(float x) { const u32x2 r = __builtin_amdgcn_permlane16_swap(__float_as_uint(x), __float_as_uint(x), false, false); return fmaxf(__uint_as_float(r[0]), __uint_as_float(r[1])); }
__device__ __forceinline__ float xmax32(float x) { const u32x2 r = __builtin_amdgcn_permlane32_swap(__float_as_uint(x), __float_as_uint(x), false, false); return fmaxf(__uint_as_float(r[0]), __uint_as_float(r[1])); }
__device__ __forceinline__ float wave_sum(float v, int lane) {
#pragma unroll
    for (int o = 1; o < 64; o <<= 1) v += SHX(v, o);
    return v;
}
__device__ __forceinline__ int bidx() { int b = (int)blockIdx.x; asm volatile("" : "+s"(b)); return b; }
__device__ __forceinline__ float fast_exp2(float x) { return __builtin_amdgcn_exp2f(x); }
__device__ __forceinline__ float silu_f(float x) { return x * __builtin_amdgcn_rcpf(1.0f + __builtin_amdgcn_exp2f(-x * LOG2E)); }
__device__ __forceinline__ s16x4 tr_read(const LAS unsigned char* p) {
    typedef short v4i16_t __attribute__((ext_vector_type(4)));
    return __builtin_bit_cast(s16x4, __builtin_amdgcn_ds_read_tr16_b64_v4i16((LAS v4i16_t*)p));
}
__device__ __forceinline__ bf16x8 cat4(s16x4 lo, s16x4 hi) { bf16x8 r; r[0] = lo[0]; r[1] = lo[1]; r[2] = lo[2]; r[3] = lo[3]; r[4] = hi[0]; r[5] = hi[1]; r[6] = hi[2]; r[7] = hi[3]; return r; }
__device__ __forceinline__ bf16x8 u4_to_bf8(u32x4 w) { return __builtin_bit_cast(bf16x8, w); }
__device__ __forceinline__ f32x4 mfma16(bf16x8 a, bf16x8 b, f32x4 c) { return __builtin_amdgcn_mfma_f32_16x16x32_bf16(a, b, c, 0, 0, 0); }

namespace pg8 {
constexpr int BM = 256, BK = 64, HALF = 128, HTB = HALF * BK * 2, STAGE_BYTES = 8 * HTB, NXCD = 8, WGM = 8;
__host__ __device__ __forceinline__ int lds_byte(int r, int c) { const int st = (r >> 4) * 2 + (c >> 5), rr = r & 15, cc = c & 31, ob = rr * 64 + cc * 2; return st * 1024 + (ob ^ (((ob >> 9) & 1) << 5)); }
__host__ __device__ __forceinline__ void stage_rc(int b, int& R, int& C) { const int st = b / 1024, sb = b % 1024, swz = sb ^ (((sb >> 9) & 1) << 5); R = (st >> 1) * 16 + swz / 64; C = (st & 1) * 32 + (swz % 64) / 2; }
__host__ __device__ __forceinline__ int perm32(int rho) { const int n = rho >> 4, i = rho & 15; return 8 * (i >> 2) + 4 * n + (i & 3); }

struct Unit { int pm, pn; };
struct Gemm { const bf16_t* A; const bf16_t* Bt; int M, N, K; const int* rowidx; };

struct StaticOrder {
    int nM, nN, nwg, G, c;
    __device__ void init(int M, int N, int G_, int c_) { nM = M / BM; nN = N / BM; nwg = nM * nN; G = G_; c = c_; }
    __device__ bool next(int i, Unit& u) const {
        const long L = (long)i * G + c; if (L >= nwg) return false;
        int wgid = (int)L; { const int q = nwg / NXCD, r = nwg % NXCD, xcd = wgid % NXCD, off = wgid / NXCD; wgid = (xcd < r ? xcd * (q + 1) : r * (q + 1) + (xcd - r) * q) + off; }
        const int nig = WGM * nN, gid = wgid / nig, fm = gid * WGM, gsz = (nM - fm) < WGM ? (nM - fm) : WGM;
        u.pm = fm + ((wgid % nig) % gsz); u.pn = (wgid % nig) / gsz; return true;
    }
};
struct DiagOrder {
    int c;
    __device__ bool next(int i, Unit& u) const { if (i != 0 || c >= 32) return false; const int l = c >> 3, j = c & 7; u.pm = 2 * l + (j >> 2); u.pn = 4 * l + (j & 3); return true; }
};
struct MoeOrder {
    int G, c;
    __device__ bool next(int i, Unit& u) const {
        const long v = (long)i * G + c; if (v >= 1024) return false;
        int uu = (int)v;
        if (G == 256) { const int x = c & 7, j = c >> 3; uu = (i * 8 + x) * 32 + j; }
        const int grp = uu >> 5, j = uu & 31, e = grp >> 1, b = grp & 1;
        u.pm = (b * NEXP + e) * 4 + (j >> 3); u.pn = e * 8 + (j & 7); return true;
    }
};

struct EpiProj {
    static constexpr bool PERM = true;
    bf16_t* O; int ldc; float* part; int nh; unsigned long long need; const float* rowscale;
    static constexpr bool HAS_PRE = true;
    __device__ __forceinline__ void pre(const Unit& u, int wr, int fr, f32x4 (&pv)[1]) const {
        const int row0 = u.pm * BM + wr * 64 + fr;
#pragma unroll
        for (int q = 0; q < 4; ++q) pv[0][q] = rowscale ? rowscale[row0 + q * 16] : 1.0f; }
    __device__ __forceinline__ void operator()(const f32x4 (&acc)[2][2][4][2], const Unit& u, int wr, int wc, int fr, int fq, const f32x4 (&pv)[1]) const {
        const int row0 = u.pm * BM + wr * 64 + fr, col0 = u.pn * BM + wc * 32 + 8 * fq;
        const bool nd0 = (need >> (u.pn * 2)) & 1ull, nd1 = (need >> (u.pn * 2 + 1)) & 1ull;
        f32x4 pw; pw[0] = rowscale ? rowscale[row0 + HALF] : 1.0f; pw[1] = rowscale ? rowscale[row0 + HALF + 16] : 1.0f; pw[2] = rowscale ? rowscale[row0 + HALF + 32] : 1.0f; pw[3] = rowscale ? rowscale[row0 + HALF + 48] : 1.0f;
#pragma unroll
        for (int ai = 0; ai < 2; ++ai)
#pragma unroll
            for (int m = 0; m < 4; ++m) { const int row = row0 + ai * HALF + m * 16; bf16_t* rowp = O + (size_t)row * ldc + col0; const float rsc = ai ? pw[m] : pv[0][m];
#pragma unroll
                for (int bj = 0; bj < 2; ++bj) { const f32x4 v0 = acc[ai][bj][m][0] * rsc, v1 = acc[ai][bj][m][1] * rsc;
                    u32x4 w; w.x = pk2(v0[0], v0[1]); w.y = pk2(v0[2], v0[3]); w.z = pk2(v1[0], v1[1]); w.w = pk2(v1[2], v1[3]);
                    *(u32x4*)(rowp + bj * HALF) = w;
                    if (bj ? nd1 : nd0) {
                        float ss = (v0[0] * v0[0] + v0[1] * v0[1]) + (v0[2] * v0[2] + v0[3] * v0[3]) + (v1[0] * v1[0] + v1[1] * v1[1]) + (v1[2] * v1[2] + v1[3] * v1[3]);
                        { const int lane = fq * 16 + fr; ss = xadd16(ss); ss = xadd32(ss); }
                        if (fq == 0) part[((size_t)row * nh + (u.pn * 2 + bj)) * 4 + wc] = ss; } } }
    }
};
struct EpiResid {
    static constexpr bool PERM = false;
    float* X; int ldc;
    __device__ __forceinline__ void operator()(const f32x4 (&acc)[2][2][4][2], const Unit& u, int wr, int wc, int fr, int fq) const {
        const int row0 = u.pm * BM + wr * 64 + fr, col0 = u.pn * BM + wc * 32 + 4 * fq;
#pragma unroll
        for (int ai = 0; ai < 2; ++ai)
#pragma unroll
            for (int m = 0; m < 4; ++m) { float* rowp = X + (size_t)(row0 + ai * HALF + m * 16) * ldc + col0;
#pragma unroll
                for (int bj = 0; bj < 2; ++bj)
#pragma unroll
                    for (int n = 0; n < 2; ++n) { f32x4* q = (f32x4*)(rowp + bj * HALF + n * 16); *q = *q + acc[ai][bj][m][n]; }
                if (m == 3) asm volatile("" ::: "memory"); }
    }
};
struct EpiDelta {
    static constexpr bool PERM = true;
    bf16_t* O; int ldc; const bf16_t* X;
    static constexpr bool HAS_PRE = false;
    __device__ __forceinline__ void pre(const Unit&, int, int, f32x4 (&)[1]) const {}
    __device__ __forceinline__ void operator()(const f32x4 (&acc)[2][2][4][2], const Unit& u, int wr, int wc, int fr, int fq, const f32x4 (&)[1]) const {
        const int row0 = u.pm * BM + wr * 64 + fr, col0 = u.pn * BM + wc * 32 + 8 * fq;
        u32x4 xv[2][4][2];
#pragma unroll
        for (int ai = 0; ai < 2; ++ai)
#pragma unroll
            for (int m = 0; m < 4; ++m)
#pragma unroll
                for (int bj = 0; bj < 2; ++bj) xv[ai][m][bj] = *(const u32x4*)(X + (size_t)(row0 + ai * HALF + m * 16) * ldc + col0 + bj * HALF);
#pragma unroll
        for (int ai = 0; ai < 2; ++ai)
#pragma unroll
            for (int m = 0; m < 4; ++m) { bf16_t* rowp = O + (size_t)(row0 + ai * HALF + m * 16) * ldc + col0;
#pragma unroll
                for (int bj = 0; bj < 2; ++bj) { const f32x4 v0 = acc[ai][bj][m][0], v1 = acc[ai][bj][m][1]; const u32x4 x = xv[ai][m][bj];
                    u32x4 w; w.x = pk2(v0[0] + __uint_as_float(x.x << 16), v0[1] + __uint_as_float(x.x & 0xffff0000u)); w.y = pk2(v0[2] + __uint_as_float(x.y << 16), v0[3] + __uint_as_float(x.y & 0xffff0000u));
                    w.z = pk2(v1[0] + __uint_as_float(x.z << 16), v1[1] + __uint_as_float(x.z & 0xffff0000u)); w.w = pk2(v1[2] + __uint_as_float(x.w << 16), v1[3] + __uint_as_float(x.w & 0xffff0000u));
                    *(u32x4*)(rowp + bj * HALF) = w; } }
    }
};
struct EpiSwiglu {
    static constexpr bool PERM = true;
    bf16_t* O; const float* rss;
    static constexpr bool HAS_PRE = true;
    __device__ __forceinline__ void pre(const Unit& u, int wr, int fr, f32x4 (&pv)[1]) const {
        const int row0 = u.pm * BM + wr * 64 + fr;
#pragma unroll
        for (int q = 0; q < 4; ++q) pv[0][q] = rss[row0 + q * 16]; }
    __device__ __forceinline__ void operator()(const f32x4 (&acc)[2][2][4][2], const Unit& u, int wr, int wc, int fr, int fq, const f32x4 (&pv)[1]) const {
        const int row0 = u.pm * BM + wr * 64 + fr, col0 = (u.pn & 7) * 128 + wc * 32 + 8 * fq;
        f32x4 pw; pw[0] = rss[row0 + HALF]; pw[1] = rss[row0 + HALF + 16]; pw[2] = rss[row0 + HALF + 32]; pw[3] = rss[row0 + HALF + 48];
#pragma unroll
        for (int ai = 0; ai < 2; ++ai)
#pragma unroll
            for (int m = 0; m < 4; ++m) { const float rsc = ai ? pw[m] : pv[0][m];
                const f32x4 g0 = acc[ai][0][m][0] * rsc, g1 = acc[ai][0][m][1] * rsc, u0 = acc[ai][1][m][0] * rsc, u1 = acc[ai][1][m][1] * rsc;
                u32x4 w; w.x = pk2(silu_f(g0[0]) * u0[0], silu_f(g0[1]) * u0[1]); w.y = pk2(silu_f(g0[2]) * u0[2], silu_f(g0[3]) * u0[3]);
                w.z = pk2(silu_f(g1[0]) * u1[0], silu_f(g1[1]) * u1[1]); w.w = pk2(silu_f(g1[2]) * u1[2], silu_f(g1[3]) * u1[3]);
                *(u32x4*)(O + (size_t)(row0 + ai * HALF + m * 16) * FF + col0) = w; }
    }
};
struct EpiDown {
    static constexpr bool PERM = true;
    bf16_t* O; const float* gate;
    static constexpr bool HAS_PRE = true;
    __device__ __forceinline__ void pre(const Unit& u, int wr, int fr, f32x4 (&pv)[1]) const {
        const int row0 = u.pm * BM + wr * 64 + fr;
#pragma unroll
        for (int q = 0; q < 4; ++q) pv[0][q] = gate[row0 + q * 16]; }
    __device__ __forceinline__ void operator()(const f32x4 (&acc)[2][2][4][2], const Unit& u, int wr, int wc, int fr, int fq, const f32x4 (&pv)[1]) const {
        const int row0 = u.pm * BM + wr * 64 + fr, col0 = (u.pn & 7) * BM + wc * 32 + 8 * fq;
        f32x4 pw; pw[0] = gate[row0 + HALF]; pw[1] = gate[row0 + HALF + 16]; pw[2] = gate[row0 + HALF + 32]; pw[3] = gate[row0 + HALF + 48];
#pragma unroll
        for (int ai = 0; ai < 2; ++ai)
#pragma unroll
            for (int m = 0; m < 4; ++m) { const int row = row0 + ai * HALF + m * 16; const float gt = ai ? pw[m] : pv[0][m]; bf16_t* rowp = O + (size_t)row * DM + col0;
#pragma unroll
                for (int bj = 0; bj < 2; ++bj) { const f32x4 v0 = acc[ai][bj][m][0] * gt, v1 = acc[ai][bj][m][1] * gt;
                    u32x4 w; w.x = pk2(v0[0], v0[1]); w.y = pk2(v0[2], v0[3]); w.z = pk2(v1[0], v1[1]); w.w = pk2(v1[2], v1[3]);
                    *(u32x4*)(rowp + bj * HALF) = w; } }
    }
};

template <class Epi, class Sched, bool GATHER, int B_AUX = 0>
__device__ __forceinline__ void gemm_phase(LAS unsigned char* lds, const Gemm g, const Sched& S, const Epi& E) {
    int tid = threadIdx.x; asm volatile("" : "+v"(tid));
    const int wid = __builtin_amdgcn_readfirstlane(tid >> 6), lane = tid & 63, wr = wid >> 2, wc = wid & 3, fr = lane & 15, fq = lane >> 4;
    const int K = g.K, nt = K / BK;
    unsigned voffA[2], voffB[2];
#pragma unroll
    for (int i = 0; i < 2; ++i) { int R, C; stage_rc(tid * 16 + i * 8192, R, C); const int Rb = Epi::PERM ? ((R & ~31) + perm32(R & 31)) : R;
        voffA[i] = (unsigned)(R * K + C) * 2u; voffB[i] = (unsigned)(Rb * K + C) * 2u; }
    const size_t kstep = (size_t)(BK * 2);
    const size_t hstep = (size_t)HALF * K * 2;
    const size_t tstep = 2 * hstep;
    const unsigned ldsw = (unsigned)wid * 1024u;
    const int aoff = lds_byte(wr * 64 + fr, fq * 8), boff = lds_byte(wc * 32 + fr, fq * 8);
    unsigned gA[2][2];
#define PG8_SA(b, h) (((b) * 2 + (h)) * HTB)
#define PG8_SB(b, h) ((4 + (b) * 2 + (h)) * HTB)
#define PG8_STAGE(bufoff, gbase, voff) do { _Pragma("unroll") for (int _i = 0; _i < 2; ++_i) \
        __builtin_amdgcn_global_load_lds((const unsigned*)((const char*)(gbase) + (voff)[_i]), (LAS unsigned*)(lds + (bufoff) + ldsw + _i * 8192), 16, 0, 0); } while (0)
#define PG8_STAGEB(bufoff, gbase, voff) do { _Pragma("unroll") for (int _i = 0; _i < 2; ++_i) \
        __builtin_amdgcn_global_load_lds((const unsigned*)((const char*)(gbase) + (voff)[_i]), (LAS unsigned*)(lds + (bufoff) + ldsw + _i * 8192), 16, 0, B_AUX); } while (0)
#define PG8_ASTAGE(b, h, kp, NX) do { if constexpr (GATHER) { PG8_STAGE(PG8_SA(b, h), kp, gA[h]); } \
        else { PG8_STAGE(PG8_SA(b, h), (kp) + (h) * hstep, voffA); } } while (0)
#define PG8_ROWS(dst, un) do { _Pragma("unroll") for (int _i = 0; _i < 2; ++_i) { int _R, _C; stage_rc(tid * 16 + _i * 8192, _R, _C); _Pragma("unroll") for (int _h = 0; _h < 2; ++_h) \
        dst[_h][_i] = (unsigned)g.rowidx[(un).pm * BM + _h * HALF + _R] * (unsigned)(K * 2) + (unsigned)_C * 2u; } } while (0)
#define PG8_LDA(dst, b, h) do { _Pragma("unroll") for (int m = 0; m < 4; ++m) _Pragma("unroll") for (int k = 0; k < 2; ++k) dst[m][k] = *(const LAS bf16x8*)(lds + PG8_SA(b, h) + aoff + m * 2048 + k * 1024); } while (0)
#define PG8_LDB(dst, b, h) do { _Pragma("unroll") for (int n = 0; n < 2; ++n) _Pragma("unroll") for (int k = 0; k < 2; ++k) dst[n][k] = *(const LAS bf16x8*)(lds + PG8_SB(b, h) + boff + n * 2048 + k * 1024); } while (0)
#define PG8_MMA(ai, bj, At, Bt) do { __builtin_amdgcn_s_setprio(1); _Pragma("unroll") for (int m = 0; m < 4; ++m) _Pragma("unroll") for (int n = 0; n < 2; ++n) _Pragma("unroll") for (int k = 0; k < 2; ++k) \
        acc[ai][bj][m][n] = __builtin_amdgcn_mfma_f32_16x16x32_bf16(Bt[n][k], At[m][k], acc[ai][bj][m][n], 0, 0, 0); __builtin_amdgcn_s_setprio(0); } while (0)
#define PG8_WAIT_V(n) asm volatile("s_waitcnt vmcnt(" #n ")" ::: "memory")
#define PG8_WAIT_L(n) asm volatile("s_waitcnt lgkmcnt(" #n ")" ::: "memory")
#define PG8_BAR __builtin_amdgcn_s_barrier()
#define PG8_SCHED __builtin_amdgcn_sched_barrier(0)
    Unit cur, nxt; int ui = 0;
    if (!S.next(0, cur)) return;
    f32x4 acc[2][2][4][2];
#pragma unroll
    for (int a = 0; a < 2; ++a)
#pragma unroll
        for (int b = 0; b < 2; ++b)
#pragma unroll
            for (int m = 0; m < 4; ++m)
#pragma unroll
                for (int n = 0; n < 2; ++n) acc[a][b][m][n] = (f32x4){0.f, 0.f, 0.f, 0.f};
    bf16x8 At[4][2], B0[2][2], B1[2][2];
    f32x4 pv[1] = {(f32x4){1.f, 1.f, 1.f, 1.f}};
    const char* cA = GATHER ? (const char*)g.A : (const char*)g.A + (size_t)cur.pm * tstep; const char* cB = (const char*)g.Bt + (size_t)cur.pn * tstep;
    if constexpr (GATHER) { PG8_ROWS(gA, cur); }
    PG8_STAGEB(PG8_SB(0, 0), cB, voffB); PG8_STAGEB(PG8_SB(0, 1), cB + hstep, voffB); PG8_ASTAGE(0, 0, cA, false); PG8_ASTAGE(0, 1, cA, false);
    if (wr == 1) PG8_BAR;
    PG8_WAIT_V(2); PG8_BAR;
    PG8_STAGEB(PG8_SB(1, 0), cB + kstep, voffB); PG8_ASTAGE(1, 0, cA + kstep, false); PG8_STAGEB(PG8_SB(1, 1), cB + hstep + kstep, voffB);
    PG8_WAIT_V(6); PG8_BAR;
    for (;;) {
        const bool has_next = S.next(ui + 1, nxt);
        const char* nA = has_next ? (GATHER ? (const char*)g.A : (const char*)g.A + (size_t)nxt.pm * tstep) : cA; const char* nB = has_next ? (const char*)g.Bt + (size_t)nxt.pn * tstep : cB;
        for (int t = 0; t < nt; t += 2) {
            const bool last = (t == nt - 2);
            const char* a1 = cA + (size_t)(t + 1) * kstep;
            const char* a2 = last ? nA : cA + (size_t)(t + 2) * kstep; const char* b2 = last ? nB : cB + (size_t)(t + 2) * kstep;
            const char* a3 = a2 + kstep; const char* b3 = b2 + kstep;
            if constexpr (Epi::HAS_PRE) { if (last) E.pre(cur, wr, fr, pv); }
            PG8_LDB(B0, 0, 0); PG8_LDB(B1, 0, 1); PG8_SCHED; PG8_LDA(At, 0, 0); PG8_ASTAGE(1, 1, a1, false);
            if constexpr (GATHER) { if (last && has_next) { PG8_ROWS(gA, nxt); } }
            PG8_WAIT_V(8); PG8_WAIT_L(0); PG8_BAR; PG8_MMA(0, 0, At, B0); PG8_MMA(0, 1, At, B1); PG8_BAR; PG8_SCHED;
            PG8_LDA(At, 0, 1); PG8_STAGEB(PG8_SB(0, 0), b2, voffB); PG8_STAGEB(PG8_SB(0, 1), b2 + hstep, voffB); PG8_ASTAGE(0, 0, a2, last);
            PG8_WAIT_V(8); PG8_WAIT_L(0); PG8_BAR; PG8_MMA(1, 0, At, B0); PG8_MMA(1, 1, At, B1); PG8_BAR; PG8_SCHED;
            PG8_LDB(B0, 1, 0); PG8_LDB(B1, 1, 1); PG8_SCHED; PG8_LDA(At, 1, 0); PG8_ASTAGE(0, 1, a2, last);
            PG8_WAIT_V(8); PG8_WAIT_L(0); PG8_BAR; PG8_MMA(0, 0, At, B0); PG8_MMA(0, 1, At, B1); PG8_BAR; PG8_SCHED;
            PG8_LDA(At, 1, 1); PG8_STAGEB(PG8_SB(1, 0), b3, voffB); PG8_STAGEB(PG8_SB(1, 1), b3 + hstep, voffB); PG8_ASTAGE(1, 0, a3, last);
            PG8_WAIT_V(8); PG8_WAIT_L(0); PG8_BAR; PG8_MMA(1, 0, At, B0); PG8_MMA(1, 1, At, B1); PG8_BAR; PG8_SCHED;
        }
        if (wr == 0) PG8_BAR;
        E(acc, cur, wr, wc, fr, fq, pv);
        if (DUP_ON(21)) { asm volatile("" ::: "memory"); E(acc, cur, wr, wc, fr, fq, pv); }
        if (!has_next) break;
#pragma unroll
        for (int a = 0; a < 2; ++a)
#pragma unroll
            for (int b = 0; b < 2; ++b)
#pragma unroll
                for (int m = 0; m < 4; ++m)
#pragma unroll
                    for (int n = 0; n < 2; ++n) acc[a][b][m][n] = (f32x4){0.f, 0.f, 0.f, 0.f};
        cur = nxt; cA = nA; cB = nB; ++ui;
        if (wr == 1) PG8_BAR;
    }
    PG8_WAIT_V(0);
    PG8_BAR;
#undef PG8_SA
#undef PG8_SB
#undef PG8_STAGE
#undef PG8_ASTAGE
#undef PG8_STAGEB
#undef PG8_ROWS
#undef PG8_LDA
#undef PG8_LDB
#undef PG8_MMA
#undef PG8_WAIT_V
#undef PG8_WAIT_L
#undef PG8_BAR
#undef PG8_SCHED
}
}

#define XB_TMO      128
#define XB_XCNT(j)  (256  + 64 * (j))
#define XB_XSUB(j)  (1280 + 64 * (j))
#define XB_XGEN(j)  (2304 + 64 * (j))
#define XB_TOP      3328
#define XB_TOPGEN   3392
#define XCD_BAR_WORDS 3456
#define XB_SPIN_CAP (1u << 18)
__device__ __forceinline__ unsigned xb_ld(unsigned* p)              { return __hip_atomic_load(p, __ATOMIC_RELAXED, __HIP_MEMORY_SCOPE_AGENT); }
__device__ __forceinline__ unsigned xb_add(unsigned* p, unsigned v) { return __hip_atomic_fetch_add(p, v, __ATOMIC_RELAXED, __HIP_MEMORY_SCOPE_AGENT); }
__device__ __forceinline__ unsigned xb_xcc_id() { return (unsigned)__builtin_amdgcn_s_getreg((3 << 11) | 20) & 0xFu; }
#define XB_SPIN(cond, bar) do { unsigned _sp = 0; while (cond) { \
    if ((++_sp & 255u) == 0u) { if (xb_ld(&(bar)[XB_TMO])) break; if (_sp > XB_SPIN_CAP) { atomicAdd(&(bar)[XB_TMO], 1u); break; } } } } while (0)
struct XcdBarrier { unsigned* bar; unsigned x; volatile LAS unsigned* st; };
__device__ __forceinline__ XcdBarrier xcd_barrier_post(unsigned* bar, volatile LAS unsigned* st) {
    XcdBarrier b; b.bar = bar; b.x = xb_xcc_id(); b.st = st;
    if (threadIdx.x == 0) (void)xb_add(&bar[XB_XCNT(b.x)], 1u);
    return b;
}
__device__ __forceinline__ void xcd_barrier_complete(unsigned* bar, unsigned x, unsigned& nloc, unsigned& nx) {
    const unsigned G = gridDim.x * gridDim.y * gridDim.z;
    unsigned sum, cnt, mine, sp = 0u;
    for (;;) {
        sum = 0u; cnt = 0u; mine = 0u;
#pragma unroll
        for (unsigned j = 0; j < 16; ++j) { const unsigned c = xb_ld(&bar[XB_XCNT(j)]); sum += c; cnt += (c > 0u) ? 1u : 0u; mine = (j == x) ? c : mine; }
        if (sum == G) break;
        __builtin_amdgcn_s_sleep(1);
        if ((++sp & 255u) == 0u) { if (xb_ld(&bar[XB_TMO])) break; if (sp > XB_SPIN_CAP) { atomicAdd(&bar[XB_TMO], 1u); break; } }
    }
    nloc = mine > 0u ? mine : 1u; nx = cnt > 0u ? cnt : 1u;
}
__device__ __noinline__ void xcd_barrier_impl(unsigned* bar_, unsigned x_, volatile LAS unsigned* st_) {
    XcdBarrier b; b.bar = bar_; b.x = x_; b.st = st_;
    asm volatile("s_waitcnt vmcnt(0)" ::: "memory");
    __syncthreads();
    if (threadIdx.x == 0) {
        unsigned* bar = b.bar;
        __builtin_amdgcn_s_waitcnt(0);
        unsigned nloc = b.st[0], nx = b.st[1];
        if (nloc == 0u) { xcd_barrier_complete(bar, b.x, nloc, nx); b.st[0] = nloc; b.st[1] = nx; }
        const unsigned old = xb_add(&bar[XB_XSUB(b.x)], 1u);
        const unsigned gen = old / nloc;
        if (old + 1u == (gen + 1u) * nloc) {
            __builtin_amdgcn_fence(__ATOMIC_RELEASE, "agent");
            asm volatile("s_waitcnt vmcnt(0)" ::: "memory");
            const unsigned og = xb_add(&bar[XB_TOP], 1u);
            const unsigned tg = og / nx;
            if (og + 1u == (tg + 1u) * nx) xb_add(&bar[XB_TOPGEN], 1u);
            else XB_SPIN(xb_ld(&bar[XB_TOPGEN]) == tg, bar);
            __builtin_amdgcn_fence(__ATOMIC_ACQUIRE, "agent");
            xb_add(&bar[XB_XGEN(b.x)], 1u);
            asm volatile("s_waitcnt vmcnt(0)" ::: "memory");
        } else {
            XB_SPIN(xb_ld(&bar[XB_XGEN(b.x)]) == gen, bar);
            __builtin_amdgcn_fence(__ATOMIC_ACQUIRE, "agent");
            asm volatile("s_waitcnt vmcnt(0)" ::: "memory");
        }
    }
    __syncthreads();
}

__device__ __forceinline__ void xcd_barrier(const XcdBarrier& b) { xcd_barrier_impl(b.bar, b.x, b.st); }

struct Params { const float* in[21]; float* out; unsigned char* ws; int lo, hi, li, pad; };
enum { I_X = 0, I_MEM, I_N1G, I_WINA, I_AQG, I_AKG, I_SINK, I_WINR, I_RDF, I_RDB, I_ROG, I_MNG, I_WMKV, I_CQG, I_CKG, I_WOUT, I_N2G, I_WR, I_WG, I_WU, I_WD };

__device__ __forceinline__ void transpose_item(const float* src, int N, int K, bf16_t* dst, int drow0, int k0, int n0, LAS unsigned* scr, int lane, const float* kgain = nullptr) {
    f32x4 v[16];
    const int c4 = (lane & 15) * 4, kr = lane >> 4;
#pragma unroll
    for (int j = 0; j < 16; ++j) v[j] = __builtin_nontemporal_load((const f32x4*)(src + (size_t)(k0 + 4 * j + kr) * N + n0 + c4));
#pragma unroll
    for (int j = 0; j < 16; ++j) { const int k = 4 * j + kr; const float gk = kgain ? kgain[k0 + k] : 1.0f;
        scr[k * 33 + (lane & 15) * 2] = pk2(v[j][0] * gk, v[j][1] * gk); scr[k * 33 + (lane & 15) * 2 + 1] = pk2(v[j][2] * gk, v[j][3] * gk); }
    asm volatile("s_waitcnt lgkmcnt(0)" ::: "memory");
    const LAS unsigned short* sh = (const LAS unsigned short*)scr;
    const int kc = lane & 7;
#pragma unroll
    for (int jj = 0; jj < 8; ++jj) { const int n = (lane >> 3) + 8 * jj;
        unsigned h[8];
#pragma unroll
        for (int e = 0; e < 8; ++e) h[e] = sh[(8 * kc + e) * 66 + n];
        u32x4 w; w.x = h[0] | (h[1] << 16); w.y = h[2] | (h[3] << 16); w.z = h[4] | (h[5] << 16); w.w = h[6] | (h[7] << 16);
        __builtin_nontemporal_store(w, (u32x4*)(dst + (size_t)(drow0 + n) * K + k0 + 8 * kc)); }
    asm volatile("s_waitcnt lgkmcnt(0)" ::: "memory");
}
__device__ __forceinline__ void phase_convert(const Params& p, bool moe_too, int part, LAS unsigned char* lds, int gw, int ngw, int wave, int lane) {
    LAS unsigned* scr = (LAS unsigned*)(lds + wave * 8448);
    unsigned char* ws = p.ws;
    constexpr int C0 = 2 * 1536, C1 = C0 + 2 * 2560, C2 = C1 + 4 * 512, C3 = C2 + 4 * 1024, C4 = C3 + 64 * 512, C5 = C4 + 64 * 512, C6 = C5 + 64 * 512;
    const int nj = part == 0 ? (moe_too ? C6 : C3) : (part == 1 ? 1536 + 2048 : C3 - 1536 - 2048);
    for (int j = gw; j < nj; j += ngw) {
        const int it = part == 0 ? j : (part == 1 ? (j < 1536 ? j : C1 + (j - 1536)) : (j < C1 - 1536 ? 1536 + j : C2 + (j - (C1 - 1536))));
        if (it < C0) { const int mat = it / 1536, r = it % 1536, kb = r / 48, nb = r % 48;
            transpose_item(p.in[I_WINA] + (size_t)mat * DM * ATT_W, ATT_W, DM, (bf16_t*)(ws + WS_WINA) + (size_t)mat * ATT_W * DM, 64 * nb, 64 * kb, 64 * nb, scr, lane, p.in[I_N1G] + (size_t)(2 * mat) * DM); }
        else if (it < C1) { const int q = it - C0, mat = q / 2560, r = q % 2560, kb = r / 80, nb = r % 80;
            transpose_item(p.in[I_WINR] + (size_t)mat * DM * RET_W, RET_W, DM, (bf16_t*)(ws + WS_WINR) + (size_t)mat * RET_W * DM, 64 * nb, 64 * kb, 64 * nb, scr, lane, p.in[I_N1G] + (size_t)(2 * mat + 1) * DM); }
        else if (it < C2) { const int q = it - C1, mat = q / 512, r = q % 512, kb = r / 16, nb = r % 16;
            transpose_item(p.in[I_WMKV] + (size_t)mat * DM * 1024, 1024, DM, (bf16_t*)(ws + WS_WMKV) + (size_t)mat * 1024 * DM, 64 * nb, 64 * kb, 64 * nb, scr, lane); }
        else if (it < C3) { const int q = it - C2, mat = q / 1024, r = q % 1024, kb = r / 32, nb = r % 32;
            transpose_item(p.in[I_WOUT] + (size_t)mat * DM * DM, DM, DM, (bf16_t*)(ws + WS_WOUT) + (size_t)mat * DM * DM, 64 * nb, 64 * kb, 64 * nb, scr, lane); }
        else if (it < C5) { const int up = it >= C4; const int q = it - (up ? C4 : C3), mat = q / 512, r = q % 512, kb = r / 16, nb = r % 16;
            const int n0 = 64 * nb, drow0 = 256 * (n0 >> 7) + 128 * up + (n0 & 127);
            transpose_item(p.in[up ? I_WU : I_WG] + (size_t)mat * DM * FF, FF, DM, (bf16_t*)(ws + WS_WGU) + (size_t)mat * 2048 * DM, drow0, 64 * kb, n0, scr, lane, p.in[I_N2G] + (size_t)(mat >> 4) * DM); }
        else { const int q = it - C5, mat = q / 512, r = q % 512, kb = r / 32, nb = r % 32;
            transpose_item(p.in[I_WD] + (size_t)mat * FF * DM, DM, FF, (bf16_t*)(ws + WS_WDN) + (size_t)mat * DM * FF, 64 * nb, 64 * kb, 64 * nb, scr, lane); }
    }
    bf16_t* memn = (bf16_t*)(ws + WS_MEMN);
    for (int r = gw; r < (part == 2 ? 0 : 4 * 512); r += ngw) { const int l = r >> 9, m = r & 511;
        const float* xr = p.in[I_MEM] + (size_t)m * DM; const float* gn = p.in[I_MNG] + l * DM;
        f32x4 v[8]; float ss = 0.f;
#pragma unroll
        for (int j = 0; j < 8; ++j) { v[j] = *(const f32x4*)(xr + 256 * j + 4 * lane); ss += (v[j][0] * v[j][0] + v[j][1] * v[j][1]) + (v[j][2] * v[j][2] + v[j][3] * v[j][3]); }
        const float rs = 1.0f / sqrtf(wave_sum(ss, lane) * (1.0f / DM) + EPS);
#pragma unroll
        for (int j = 0; j < 8; ++j) { const f32x4 gg = *(const f32x4*)(gn + 256 * j + 4 * lane); u32x2 w; w.x = pk2(v[j][0] * rs * gg[0], v[j][1] * rs * gg[1]); w.y = pk2(v[j][2] * rs * gg[2], v[j][3] * rs * gg[3]);
            *(u32x2*)(memn + (size_t)r * DM + 256 * j + 4 * lane) = w; }
    }
}

__device__ __forceinline__ void convert_moe_layer(const Params& p, int L, int i0, int i1, int w, int nw, LAS unsigned char* lds, int wave, int lane) {
    LAS unsigned* scr = (LAS unsigned*)(lds + wave * 8448);
    unsigned char* ws = p.ws;
    for (int i = i0 + w; i < i1; i += nw) {
        if (i < 16384) { const int up = i >= 8192; const int q = i - up * 8192, mat = L * NEXP + q / 512, r = q % 512, kb = r / 16, nb = r % 16;
            const int n0 = 64 * nb, drow0 = 256 * (n0 >> 7) + 128 * up + (n0 & 127);
            transpose_item(p.in[up ? I_WU : I_WG] + (size_t)mat * DM * FF, FF, DM, (bf16_t*)(ws + WS_WGU) + (size_t)mat * 2048 * DM, drow0, 64 * kb, n0, scr, lane, p.in[I_N2G] + (size_t)L * DM); }
        else { const int q = i - 16384, mat = L * NEXP + q / 512, r = q % 512, kb = r / 32, nb = r % 32;
            transpose_item(p.in[I_WD] + (size_t)mat * FF * DM, DM, FF, (bf16_t*)(ws + WS_WDN) + (size_t)mat * DM * FF, 64 * nb, 64 * kb, 64 * nb, scr, lane); }
    }
}

__device__ __forceinline__ void addrow_bf16(f32x4 (&v)[8], const u32x2 (&w)[8]) {
#pragma unroll
    for (int j = 0; j < 8; ++j) { v[j][0] += __uint_as_float(w[j].x << 16); v[j][1] += __uint_as_float(w[j].x & 0xffff0000u); v[j][2] += __uint_as_float(w[j].y << 16); v[j][3] += __uint_as_float(w[j].y & 0xffff0000u); }
}
__device__ __forceinline__ void combine_row(f32x4 (&v)[8], int iv, int b, const bf16_t* Y, int lane) {
    unsigned mask = (unsigned)__builtin_amdgcn_readfirstlane((int)(__ballot(iv >= 0) & 0xffffull));
    while (mask) {
        const int e0 = __builtin_ctz(mask); mask &= mask - 1u;
        const int c0 = __builtin_amdgcn_readlane(iv, e0);
        const bool two = mask != 0u;
        const int e1 = two ? __builtin_ctz(mask) : e0; if (two) mask &= mask - 1u;
        const int c1 = __builtin_amdgcn_readlane(iv, e1);
        const bf16_t* y0 = Y + (size_t)((b * NEXP + e0) * CAP + c0) * DM + 4 * lane;
        const bf16_t* y1 = Y + (size_t)((b * NEXP + e1) * CAP + c1) * DM + 4 * lane;
        u32x2 w0[8], w1[8];
#pragma unroll
        for (int j = 0; j < 8; ++j) { w0[j] = __builtin_nontemporal_load((const u32x2*)(y0 + 256 * j)); w1[j] = __builtin_nontemporal_load((const u32x2*)(y1 + 256 * j)); }
        addrow_bf16(v, w0);
        if (two) addrow_bf16(v, w1);
    }
}
__device__ __forceinline__ void xrow_finish(const f32x4 (&v)[8], int t, bool fin, float* outp, bf16_t* XB, float* rs1, int lane) {
    if (fin) {
#pragma unroll
        for (int j = 0; j < 8; ++j) __builtin_nontemporal_store(v[j], (f32x4*)(outp + (size_t)t * DM + 256 * j + 4 * lane));
    } else {
        float ss = 0.f;
#pragma unroll
        for (int j = 0; j < 8; ++j) { ss += (v[j][0] * v[j][0] + v[j][1] * v[j][1]) + (v[j][2] * v[j][2] + v[j][3] * v[j][3]);
            u32x2 w; w.x = pk2(v[j][0], v[j][1]); w.y = pk2(v[j][2], v[j][3]); *(u32x2*)(XB + (size_t)t * DM + 256 * j + 4 * lane) = w; }
        const float rs = 1.0f / sqrtf(wave_sum(ss, lane) * (1.0f / DM) + EPS);
        if (lane == 0) rs1[t] = rs;
    }
}
__device__ __forceinline__ void phase_norm1(const Params& p, int L, bool combine, bool do_norm, int gw, int ngw, int lane) {
    const int* inv = (const int*)(p.ws + WS_INV);
    const bf16_t* Y = (const bf16_t*)(p.ws + WS_Y); const bf16_t* XR = (const bf16_t*)(p.ws + WS_XR);
    bf16_t* XB = (bf16_t*)(p.ws + WS_H); float* rs1 = (float*)(p.ws + WS_RS1);
    for (int t = gw; t < TT; t += 2 * ngw) {
        const int t1 = t + ngw; const bool has1 = t1 < TT; const int t1c = has1 ? t1 : t;
        f32x4 v0[8], v1[8];
        if (!combine) {
#pragma unroll
            for (int j = 0; j < 8; ++j) { v0[j] = *(const f32x4*)(p.in[I_X] + (size_t)t * DM + 256 * j + 4 * lane); v1[j] = *(const f32x4*)(p.in[I_X] + (size_t)t1c * DM + 256 * j + 4 * lane); }
        } else {
            const int iv0 = inv[(size_t)t * 16 + (lane & 15)], iv1 = inv[(size_t)t1c * 16 + (lane & 15)];
            { u32x2 d0[8], d1[8];
#pragma unroll
              for (int j = 0; j < 8; ++j) { d0[j] = __builtin_nontemporal_load((const u32x2*)(XR + (size_t)t * DM + 256 * j + 4 * lane)); d1[j] = __builtin_nontemporal_load((const u32x2*)(XR + (size_t)t1c * DM + 256 * j + 4 * lane)); }
#pragma unroll
              for (int j = 0; j < 8; ++j) { v0[j] = (f32x4){0.f, 0.f, 0.f, 0.f}; v1[j] = (f32x4){0.f, 0.f, 0.f, 0.f}; }
              addrow_bf16(v0, d0); addrow_bf16(v1, d1); }
            combine_row(v0, iv0, t >> 13, Y, lane);
            combine_row(v1, iv1, t1c >> 13, Y, lane);
        }
        xrow_finish(v0, t, !do_norm, p.out, XB, rs1, lane);
        if (has1) xrow_finish(v1, t1, !do_norm, p.out, XB, rs1, lane);
    }
}

constexpr int RW_STRIDE = 4112, RW_LO = 16 * RW_STRIDE, RW_XCH = 2 * 16 * RW_STRIDE;
__device__ __forceinline__ void phase_router(const Params& p, int L, LAS unsigned char* lds, int gw, int ngw, int tid, int lane) {
    const int wave = __builtin_amdgcn_readfirstlane(tid >> 6);
    const float* wr = p.in[I_WR] + (size_t)L * DM * NEXP; const float* gn = p.in[I_N2G] + (size_t)L * DM;
    const bf16_t* XR = (const bf16_t*)(p.ws + WS_XR); float* rs2 = (float*)(p.ws + WS_RS2);
    float* aff = (float*)(p.ws + WS_AFF);
    const int i16 = lane & 15, g4 = lane >> 4, half = wave >> 2;
    LAS float* xch = (LAS float*)(lds + RW_XCH) + ((wave & 3) * 64 + lane) * 5;
    u32x4 xa[16];
#define RT_LOAD(dst, T0_, c0) do { int T_ = (T0_) + (wave & 3); T_ = T_ < TT / 16 ? T_ : TT / 16 - 1; const size_t ro_ = (size_t)(16 * T_ + i16) * DM + 1024 * half + 8 * g4; \
        _Pragma("unroll") for (int i = 0; i < 16; ++i) dst[i] = *(const u32x4*)(XR + ro_ + 32 * ((c0) + i)); } while (0)
#define RT_STEP(src, c0) do { _Pragma("unroll") for (int i = 0; i < 16; ++i) { float v[8]; \
            v[0] = __uint_as_float(src[i].x << 16); v[1] = __uint_as_float(src[i].x & 0xffff0000u); v[2] = __uint_as_float(src[i].y << 16); v[3] = __uint_as_float(src[i].y & 0xffff0000u); \
            v[4] = __uint_as_float(src[i].z << 16); v[5] = __uint_as_float(src[i].z & 0xffff0000u); v[6] = __uint_as_float(src[i].w << 16); v[7] = __uint_as_float(src[i].w & 0xffff0000u); \
            ss += ((v[0] * v[0] + v[1] * v[1]) + (v[2] * v[2] + v[3] * v[3])) + ((v[4] * v[4] + v[5] * v[5]) + (v[6] * v[6] + v[7] * v[7])); \
            const bf16x8 bh = *(const LAS bf16x8*)(wb + 64 * ((c0) + i)), bl = *(const LAS bf16x8*)(wb + RW_LO + 64 * ((c0) + i)); \
            acc = mfma16(u4_to_bf8(src[i]), bh, acc); acc = mfma16(u4_to_bf8(src[i]), bl, acc); } } while (0)
    int T0 = bidx() * 4;
    if (T0 < TT / 16) RT_LOAD(xa, T0, 0);
    for (int c = tid; c < DM; c += 512) { const float g = gn[c];
#pragma unroll
        for (int q = 0; q < 4; ++q) { const f32x4 w = *(const f32x4*)(wr + (size_t)c * 16 + 4 * q);
#pragma unroll
            for (int i = 0; i < 4; ++i) { const float val = w[i] * g; const unsigned hi = pk2(val, 0.f) & 0xffffu; const unsigned lo = pk2(val - __uint_as_float(hi << 16), 0.f) & 0xffffu;
                *(LAS unsigned short*)(lds + (4 * q + i) * RW_STRIDE + 2 * c) = (unsigned short)hi; *(LAS unsigned short*)(lds + RW_LO + (4 * q + i) * RW_STRIDE + 2 * c) = (unsigned short)lo; } }
    }
    __syncthreads();
    for (; T0 < TT / 16; T0 += (int)gridDim.x * 4) {
        int T = T0 + (wave & 3); const bool tile_ok = T < TT / 16; T = tile_ok ? T : TT / 16 - 1;
        const LAS unsigned char* wb = lds + i16 * RW_STRIDE + (1024 * half + 8 * g4) * 2;
        f32x4 acc = (f32x4){0.f, 0.f, 0.f, 0.f}; float ss = 0.f;
        { u32x4 xb[16];
          RT_LOAD(xb, T0, 16);
          RT_STEP(xa, 0);
          if (T0 + (int)gridDim.x * 4 < TT / 16) RT_LOAD(xa, T0 + (int)gridDim.x * 4, 0);
          RT_STEP(xb, 16); }
        ss = xadd16(ss); ss = xadd32(ss);
        if (half == 1) { xch[0] = acc[0]; xch[1] = acc[1]; xch[2] = acc[2]; xch[3] = acc[3]; xch[4] = ss; }
        __syncthreads();
        if (half == 0) {
            acc[0] += xch[0]; acc[1] += xch[1]; acc[2] += xch[2]; acc[3] += xch[3]; ss += xch[4];
            const float rs = 1.0f / sqrtf(ss * (1.0f / DM) + EPS);
            if (tile_ok && g4 == 0) __hip_atomic_store(rs2 + 16 * T + i16, rs, __ATOMIC_RELAXED, __HIP_MEMORY_SCOPE_AGENT);
#pragma unroll
            for (int r = 0; r < 4; ++r) {
                const float rst = __int_as_float(__builtin_amdgcn_ds_bpermute((4 * g4 + r) << 2, __float_as_int(rs)));
                const float lg = acc[r] * rst;
                float mx = lg; mx = fmaxf(mx, SHX(mx, 1)); mx = fmaxf(mx, SHX(mx, 2)); mx = fmaxf(mx, SHX(mx, 4)); mx = fmaxf(mx, SHX(mx, 8));
                const float pe = expf(lg - mx);
                float sm = pe; sm += SHX(sm, 1); sm += SHX(sm, 2); sm += SHX(sm, 4); sm += SHX(sm, 8);
                const int t = 16 * T + 4 * g4 + r;
                if (tile_ok) __hip_atomic_store(aff + ((size_t)((t >> 13) * NEXP + i16)) * SEQ + (t & (SEQ - 1)), pe / sm, __ATOMIC_RELAXED, __HIP_MEMORY_SCOPE_AGENT);
            }
        }
        __syncthreads();
    }
    __syncthreads();
}

__device__ __forceinline__ void router_publish(unsigned* cnt) {
    asm volatile("s_waitcnt vmcnt(0)" ::: "memory");
    __syncthreads();
    if (threadIdx.x == 0) __hip_atomic_fetch_add(cnt, 1u, __ATOMIC_RELAXED, __HIP_MEMORY_SCOPE_AGENT);
}
__device__ __forceinline__ void router_wait(unsigned* cnt, unsigned need, unsigned* tmo) {
    if (threadIdx.x < 64) {
        unsigned sp = 0;
        while ((unsigned)__builtin_amdgcn_readfirstlane((int)__hip_atomic_load(cnt, __ATOMIC_RELAXED, __HIP_MEMORY_SCOPE_AGENT)) < need) {
            __builtin_amdgcn_s_sleep(2);
            if ((++sp & 255u) == 0u) { if (__hip_atomic_load(tmo, __ATOMIC_RELAXED, __HIP_MEMORY_SCOPE_AGENT)) break; if (sp > (1u << 18)) { if (threadIdx.x == 0) atomicAdd(tmo, 1u); break; } } }
        __builtin_amdgcn_fence(__ATOMIC_ACQUIRE, "agent");
        asm volatile("s_waitcnt vmcnt(0)" ::: "memory");
    }
    __syncthreads();
}

__device__ __forceinline__ void phase_topk(const Params& p, LAS unsigned char* lds, int tid, int lane, int wave) {
    LAS unsigned* hist = (LAS unsigned*)lds;
    LAS unsigned* shw = (LAS unsigned*)(lds + 1024);
    const float* aff = (const float*)(p.ws + WS_AFF);
    int* rowidx = (int*)(p.ws + WS_ROWIDX); float* gatev = (float*)(p.ws + WS_GATEV); int* inv = (int*)(p.ws + WS_INV);
    const float* rs2 = (const float*)(p.ws + WS_RS2); float* rslot = (float*)(p.ws + WS_RSLOT);
    for (int u = bidx(); u < NB * NEXP; u += gridDim.x) {
        const int b = u >> 4, e = u & 15;
        unsigned key[16];
#pragma unroll
        for (int q = 0; q < 4; ++q) { const u32x4 w = *(const u32x4*)(aff + (size_t)u * SEQ + 16 * tid + 4 * q); key[4 * q] = w.x; key[4 * q + 1] = w.y; key[4 * q + 2] = w.z; key[4 * q + 3] = w.w; }
        unsigned prefix = 0u, mask = 0u, kk = CAP;
#pragma unroll 1
        for (int pass = 0; pass < 4; ++pass) {
            const int shift = 24 - 8 * pass;
            if (tid < 256) hist[tid] = 0u;
            __syncthreads();
#pragma unroll
            for (int i = 0; i < 16; ++i) if ((key[i] & mask) == prefix) __hip_atomic_fetch_add(&hist[(key[i] >> shift) & 255u], 1u, __ATOMIC_RELAXED, __HIP_MEMORY_SCOPE_WORKGROUP);
            __syncthreads();
            if (wave == 0) {
                const unsigned c0 = hist[255 - 4 * lane], c1 = hist[254 - 4 * lane], c2 = hist[253 - 4 * lane], c3 = hist[252 - 4 * lane];
                const unsigned tot = c0 + c1 + c2 + c3; unsigned incl = tot;
#pragma unroll
                for (int o = 1; o < 64; o <<= 1) { const unsigned y = shup_u(incl, o, lane); if (lane >= o) incl += y; }
                const unsigned excl = incl - tot;
                if (excl < kk && kk <= incl) { unsigned rem = kk - excl, bin;
                    if (rem <= c0) bin = 255 - 4 * lane; else { rem -= c0; if (rem <= c1) bin = 254 - 4 * lane; else { rem -= c1; if (rem <= c2) bin = 253 - 4 * lane; else { rem -= c2; bin = 252 - 4 * lane; } } }
                    shw[0] = bin; shw[1] = rem; }
            }
            __syncthreads();
            prefix |= shw[0] << shift; mask |= 255u << shift; kk = shw[1];
        }
        unsigned ne = 0;
#pragma unroll
        for (int i = 0; i < 16; ++i) ne += (key[i] == prefix) ? 1u : 0u;
        unsigned incl = ne;
#pragma unroll
        for (int o = 1; o < 64; o <<= 1) { const unsigned y = shup_u(incl, o, lane); if (lane >= o) incl += y; }
        if (lane == 63) shw[8 + wave] = incl;
        __syncthreads();
        unsigned eqbase = incl - ne;
#pragma unroll
        for (int w = 0; w < 8; ++w) eqbase += (w < wave) ? shw[8 + w] : 0u;
        unsigned selm = 0u, ns = 0u, er = eqbase;
#pragma unroll
        for (int i = 0; i < 16; ++i) { const bool gt = key[i] > prefix, eq = key[i] == prefix; const bool sel = gt || (eq && er < kk); er += eq ? 1u : 0u; selm |= sel ? (1u << i) : 0u; ns += sel ? 1u : 0u; }
        unsigned incl2 = ns;
#pragma unroll
        for (int o = 1; o < 64; o <<= 1) { const unsigned y = shup_u(incl2, o, lane); if (lane >= o) incl2 += y; }
        if (lane == 63) shw[16 + wave] = incl2;
        __syncthreads();
        unsigned cpos = incl2 - ns;
#pragma unroll
        for (int w = 0; w < 8; ++w) cpos += (w < wave) ? shw[16 + w] : 0u;
#pragma unroll
        for (int i = 0; i < 16; ++i) { const int tok = 16 * tid + i; const bool sel = (selm >> i) & 1u;
            if (sel) { rowidx[u * CAP + cpos] = b * SEQ + tok; gatev[u * CAP + cpos] = __uint_as_float(key[i]); rslot[u * CAP + cpos] = rs2[b * SEQ + tok]; }
            inv[((size_t)(b * SEQ + tok)) * 16 + e] = sel ? (int)cpos : -1;
            cpos += sel ? 1u : 0u; }
        __syncthreads();
    }
}

constexpr int AT_KS = 272, AT_VS = 288, AT_VOFF = 128 * AT_KS, AT_BUF = AT_VOFF + 128 * AT_VS;
__device__ __forceinline__ int xcd_vcu() { const int G = (int)gridDim.x, c = bidx(); return (G % 8 == 0) ? (c % 8) * (G / 8) + c / 8 : c; }
__device__ __forceinline__ float alibi_slope(int h) { return (h < 8) ? exp2f(-(float)(h + 1)) : exp2f(-0.5f * (float)(2 * (h - 8) + 1)); }
struct AttnU { int qrow0, krow_base, jb_lo, jb_hi, nq, qcol, kcol, vcol, ocol; float nslope2, m0; };
template <int MODE>
__device__ __forceinline__ void phase_attn_mode(const Params& p, int L, LAS unsigned char* lds, int tid, int lane, int wave) {
    const int li = L >> 1; const bool ret = (L & 1) != 0;
    const bf16_t* proj = (const bf16_t*)(p.ws + WS_PROJ); const int ldq = ret ? RET_W : ATT_W; const int qnh = ldq >> 7;
    const float* qpart = (const float*)(p.ws + WS_PART);
    const bf16_t* kvsrc = MODE == 0 ? proj : (const bf16_t*)(p.ws + WS_KVM); const int ldkv = MODE == 0 ? ldq : 4096;
    const float* kpart = MODE == 0 ? qpart : (const float*)(p.ws + WS_PARTM); const int knh = MODE == 0 ? qnh : 32;
    const float* qgain = MODE == 0 ? p.in[I_AQG] + li * 128 : p.in[I_CQG] + L * 128;
    const float* kgain = MODE == 0 ? p.in[I_AKG] + li * 128 : p.in[I_CKG] + L * 128;
    bf16_t* cat = (bf16_t*)(p.ws + WS_CAT);
    const int NU = MODE == 0 ? 1536 : 512, G = gridDim.x;
    const int i16 = lane & 15, g4 = lane >> 4;
    auto decode = [&](int u, AttnU& a) {
        if (MODE == 0) { const int hq = u % 12, n = (u / 12) & 63, b = u / 768, hk = hq / 3;
            a.qrow0 = b * SEQ + n * 128; a.krow_base = b * SEQ; a.jb_lo = n > 0 ? n - 1 : 0; a.jb_hi = n < 63 ? n + 1 : 63; a.nq = n;
            a.qcol = hq * 128; a.kcol = 1536 + hk * 128; a.vcol = 2048 + hk * 128; a.ocol = hq * 128;
            a.nslope2 = -alibi_slope(hq) * LOG2E; a.m0 = p.in[I_SINK][li * 12 + hq] * LOG2E; }
        else { const int hd = u & 3, n = (u >> 2) & 63, b = u >> 8;
            a.qrow0 = b * SEQ + n * 128; a.krow_base = L * 512 + b * MEML; a.jb_lo = 0; a.jb_hi = 1; a.nq = n;
            a.qcol = (ret ? 4608 : 2560) + hd * 128; a.kcol = L * 1024 + hd * 128; a.vcol = L * 1024 + 512 + hd * 128; a.ocol = 1536 + hd * 128;
            a.nslope2 = 0.f; a.m0 = -1e30f; }
    };
    u32x4 kraw[4], vraw[4]; f32x4 kpp[4];
    const unsigned lrow = (unsigned)(tid >> 4), lch = (unsigned)(tid & 15);
#define AT_PREFETCH(A, JB) do { const size_t kr0_ = (size_t)((A).krow_base + (JB) * 128); \
        _Pragma("unroll") for (int c = 0; c < 4; ++c) { const size_t kr_ = kr0_ + lrow + 32 * c; \
            kraw[c] = *(const u32x4*)(kvsrc + kr_ * ldkv + (A).kcol + 8 * lch); vraw[c] = *(const u32x4*)(kvsrc + kr_ * ldkv + (A).vcol + 8 * lch); \
            kpp[c] = *(const f32x4*)(kpart + (kr_ * knh + ((A).kcol >> 7)) * 4); } } while (0)
    int u = xcd_vcu(); if (u >= NU) return;
    AttnU cu, nu_; decode(u, cu);
    AT_PREFETCH(cu, cu.jb_lo);
    const f32x4 kga = *(const f32x4*)(kgain + 8 * lch), kgb = *(const f32x4*)(kgain + 8 * lch + 4);
    int bsel = 0;
    for (;;) {
        bf16x8 Qf[4];
        { const int t = cu.qrow0 + 16 * wave + i16; const f32x4 pp = *(const f32x4*)(qpart + ((size_t)t * qnh + (cu.qcol >> 7)) * 4);
          const float rq = __builtin_amdgcn_rsqf(((pp[0] + pp[1]) + (pp[2] + pp[3])) * (1.0f / 128.0f) + EPS) * QSCALE2;
#pragma unroll
          for (int ks = 0; ks < 4; ++ks) { const u32x4 raw = *(const u32x4*)(proj + (size_t)t * ldq + cu.qcol + 32 * ks + 8 * g4);
              const f32x4 ga = *(const f32x4*)(qgain + 32 * ks + 8 * g4), gb = *(const f32x4*)(qgain + 32 * ks + 8 * g4 + 4);
              u32x4 w; w.x = pk2(__uint_as_float(raw.x << 16) * rq * ga[0], __uint_as_float(raw.x & 0xffff0000u) * rq * ga[1]);
              w.y = pk2(__uint_as_float(raw.y << 16) * rq * ga[2], __uint_as_float(raw.y & 0xffff0000u) * rq * ga[3]);
              w.z = pk2(__uint_as_float(raw.z << 16) * rq * gb[0], __uint_as_float(raw.z & 0xffff0000u) * rq * gb[1]);
              w.w = pk2(__uint_as_float(raw.w << 16) * rq * gb[2], __uint_as_float(raw.w & 0xffff0000u) * rq * gb[3]);
              Qf[ks] = u4_to_bf8(w); } }
        f32x4 O[8];
#pragma unroll
        for (int d = 0; d < 8; ++d) O[d] = (f32x4){0.f, 0.f, 0.f, 0.f};
        float mrun = cu.m0, lrun = (MODE == 0 && g4 == 0) ? 1.0f : 0.0f;
        const int tq = cu.nq * 128 + 16 * wave + i16;
        const int un = u + G; const bool has_next = un < NU;
        if (has_next) decode(un, nu_);
        for (int jb = cu.jb_lo; jb <= cu.jb_hi; ++jb) {
            LAS unsigned char* ldb = lds + bsel * AT_BUF; bsel ^= 1;
#pragma unroll
            for (int c = 0; c < 4; ++c) { const float rk = __builtin_amdgcn_rsqf(((kpp[c][0] + kpp[c][1]) + (kpp[c][2] + kpp[c][3])) * (1.0f / 128.0f) + EPS);
                const u32x4 raw = kraw[c];
                u32x4 w; w.x = pk2(__uint_as_float(raw.x << 16) * rk * kga[0], __uint_as_float(raw.x & 0xffff0000u) * rk * kga[1]);
                w.y = pk2(__uint_as_float(raw.y << 16) * rk * kga[2], __uint_as_float(raw.y & 0xffff0000u) * rk * kga[3]);
                w.z = pk2(__uint_as_float(raw.z << 16) * rk * kgb[0], __uint_as_float(raw.z & 0xffff0000u) * rk * kgb[1]);
                w.w = pk2(__uint_as_float(raw.w << 16) * rk * kgb[2], __uint_as_float(raw.w & 0xffff0000u) * rk * kgb[3]);
                *(LAS u32x4*)(ldb + (lrow + 32 * c) * AT_KS + lch * 16) = w;
                *(LAS u32x4*)(ldb + AT_VOFF + (lrow + 32 * c) * AT_VS + lch * 16) = vraw[c]; }
            __syncthreads();
            if (jb < cu.jb_hi) { AT_PREFETCH(cu, jb + 1); } else if (has_next) { AT_PREFETCH(nu_, nu_.jb_lo); }
            const unsigned actm = (MODE == 1 || jb == cu.nq) ? 0xffu : (jb < cu.nq ? (0xffu << wave) & 0xffu : (0xffu >> (7 - wave)));
            f32x4 sc[8];
            float mx = -1e30f;
            const float fb = (float)(tq - jb * 128 - 4 * g4);
#pragma unroll
            for (int kt = 0; kt < 8; ++kt) {
                if ((actm >> kt) & 1u) { f32x4 a = (f32x4){0.f, 0.f, 0.f, 0.f};
#pragma unroll
                    for (int ks = 0; ks < 4; ++ks) { const bf16x8 kf = *(const LAS bf16x8*)(ldb + (16 * kt + i16) * AT_KS + (32 * ks + 8 * g4) * 2); a = mfma16(kf, Qf[ks], a); }
#pragma unroll
                    for (int r = 0; r < 4; ++r) { float v = a[r];
                        if (MODE == 0) { const float dist = fabsf(fb - (float)(16 * kt + r)); v = v + cu.nslope2 * dist; v = dist > 128.0f ? -1e30f : v; }
                        a[r] = v; mx = fmaxf(mx, v); }
                    sc[kt] = a; }
                else sc[kt] = (f32x4){-1e30f, -1e30f, -1e30f, -1e30f}; }
            mx = xmax16(mx); mx = xmax32(mx);
            const float mnew = fmaxf(mrun, mx), alpha = fast_exp2(mrun - mnew); mrun = mnew;
            float ls = 0.f;
#pragma unroll
            for (int kt = 0; kt < 8; ++kt) {
                if ((actm >> kt) & 1u) {
#pragma unroll
                    for (int r = 0; r < 4; ++r) { const float pv = fast_exp2(sc[kt][r] - mnew); sc[kt][r] = pv; ls += pv; } }
                else sc[kt] = (f32x4){0.f, 0.f, 0.f, 0.f}; }
            lrun = lrun * alpha + ls;
#pragma unroll
            for (int d = 0; d < 8; ++d) O[d] = O[d] * alpha;
            const LAS unsigned char* vb = ldb + AT_VOFF + (4 * g4 + (i16 >> 2)) * AT_VS + (4 * (i16 & 3)) * 2;
#pragma unroll
            for (int k2 = 0; k2 < 4; ++k2) {
                if ((actm >> (2 * k2)) & 3u) {
                    u32x4 w; w.x = pk2(sc[2 * k2][0], sc[2 * k2][1]); w.y = pk2(sc[2 * k2][2], sc[2 * k2][3]); w.z = pk2(sc[2 * k2 + 1][0], sc[2 * k2 + 1][1]); w.w = pk2(sc[2 * k2 + 1][2], sc[2 * k2 + 1][3]);
                    const bf16x8 pf = u4_to_bf8(w);
#pragma unroll
                    for (int d = 0; d < 8; ++d) { const s16x4 lo = tr_read(vb + (32 * k2) * AT_VS + 32 * d), hi = tr_read(vb + (32 * k2 + 16) * AT_VS + 32 * d);
                        O[d] = mfma16(cat4(lo, hi), pf, O[d]); } } }
        }
        float lt = lrun; lt = xadd16(lt); lt = xadd32(lt);
        const float il = 1.0f / lt;
        bf16_t* orow = cat + (size_t)(cu.qrow0 + 16 * wave + i16) * DM + cu.ocol + 4 * g4;
#pragma unroll
        for (int d = 0; d < 8; ++d) { u32x2 w; w.x = pk2(O[d][0] * il, O[d][1] * il); w.y = pk2(O[d][2] * il, O[d][3] * il); *(u32x2*)(orow + 16 * d) = w; }
        if (!has_next) break;
        u = un; cu = nu_;
    }
#undef AT_PREFETCH
}
__device__ __forceinline__ void phase_attn(const Params& p, int L, bool windowed, LAS unsigned char* lds, int tid, int lane, int wave) {
    if (windowed) { phase_attn_mode<0>(p, L, lds, tid, lane, wave); __syncthreads(); }
    phase_attn_mode<1>(p, L, lds, tid, lane, wave);
    __syncthreads();
}

#define GLD16(ub, lo) (*(const u32x4*)((const char*)(ub) + (lo)))
#define GLD8(ub, lo) (*(const u32x2*)((const char*)(ub) + (lo)))
__device__ __forceinline__ float log2_gamma(float x) { return -log1pf(expf(-x)) * LOG2E; }
constexpr int RT_KS = 288, RT_VS = 544;
__device__ __forceinline__ void phase_ret_kv(const Params& p, int L, LAS unsigned char* lds, int tid, int lane, int wave) {
    const int li = L >> 1; const char* proj = (const char*)(p.ws + WS_PROJ);
    bf16_t* kvc = (bf16_t*)(p.ws + WS_KVC);
    const int i16 = lane & 15, g4 = lane >> 4;
    constexpr int KIMG = 128 * RT_KS, VOFF = 2 * KIMG;
    const unsigned lk = (unsigned)((tid >> 4) * RET_W * 2 + (tid & 15) * 16), lv = (unsigned)((tid >> 5) * RET_W * 2 + (tid & 31) * 16);
    u32x4 kraw[4], vraw[8];
#define RK_PREFETCH(U) do { const int h_ = (U) % 6, n_ = ((U) / 6) & 63, b_ = (U) / 384; const char* pr_ = proj + ((size_t)b_ * SEQ + n_ * 128) * RET_W * 2; \
        _Pragma("unroll") for (int c = 0; c < 4; ++c) kraw[c] = GLD16(pr_ + (size_t)(32 * c) * RET_W * 2 + 1536 + h_ * 256, lk); \
        _Pragma("unroll") for (int c = 0; c < 8; ++c) vraw[c] = GLD16(pr_ + (size_t)(16 * c) * RET_W * 2 + 3072 + h_ * 512, lv); } while (0)
    int u = xcd_vcu(); if (u >= 768) return;
    RK_PREFETCH(u);
    for (;;) {
        const int h = u % 6, n = (u / 6) & 63, b = u / 384;
        const float lgf = log2_gamma(p.in[I_RDF][li * 6 + h]), lgb = log2_gamma(p.in[I_RDB][li * 6 + h]);
        __syncthreads();
#pragma unroll
        for (int c = 0; c < 4; ++c) { const int row = (tid >> 4) + 32 * c; const u32x4 raw = kraw[c];
#pragma unroll
            for (int dir = 0; dir < 2; ++dir) {
                const float z = fast_exp2(dir ? lgb * (float)row : lgf * (float)(127 - row));
                u32x4 w; w.x = pk2(__uint_as_float(raw.x << 16) * z, __uint_as_float(raw.x & 0xffff0000u) * z); w.y = pk2(__uint_as_float(raw.y << 16) * z, __uint_as_float(raw.y & 0xffff0000u) * z);
                w.z = pk2(__uint_as_float(raw.z << 16) * z, __uint_as_float(raw.z & 0xffff0000u) * z); w.w = pk2(__uint_as_float(raw.w << 16) * z, __uint_as_float(raw.w & 0xffff0000u) * z);
                *(LAS u32x4*)(lds + dir * KIMG + row * RT_KS + (tid & 15) * 16) = w; } }
#pragma unroll
        for (int c = 0; c < 8; ++c) *(LAS u32x4*)(lds + VOFF + ((tid >> 5) + 16 * c) * RT_VS + (tid & 31) * 16) = vraw[c];
        __syncthreads();
        const int un = u + (int)gridDim.x; const bool has_next = un < 768;
        if (has_next) RK_PREFETCH(un);
        const LAS unsigned char* vb = lds + VOFF + (4 * g4 + (i16 >> 2)) * RT_VS + (4 * (i16 & 3)) * 2 + 64 * wave;
#pragma unroll 1
        for (int dir = 0; dir < 2; ++dir) {
            f32x4 acc[8][2];
#pragma unroll
            for (int d = 0; d < 8; ++d) { acc[d][0] = (f32x4){0.f, 0.f, 0.f, 0.f}; acc[d][1] = (f32x4){0.f, 0.f, 0.f, 0.f}; }
            const LAS unsigned char* kb = lds + dir * KIMG + (4 * g4 + (i16 >> 2)) * RT_KS + (4 * (i16 & 3)) * 2;
#pragma unroll
            for (int ks = 0; ks < 4; ++ks) {
                bf16x8 bf[2];
#pragma unroll
                for (int et = 0; et < 2; ++et) bf[et] = cat4(tr_read(vb + (32 * ks) * RT_VS + 32 * et), tr_read(vb + (32 * ks + 16) * RT_VS + 32 * et));
#pragma unroll
                for (int d = 0; d < 8; ++d) { const bf16x8 af = cat4(tr_read(kb + (32 * ks) * RT_KS + 32 * d), tr_read(kb + (32 * ks + 16) * RT_KS + 32 * d));
                    acc[d][0] = mfma16(af, bf[0], acc[d][0]); acc[d][1] = mfma16(af, bf[1], acc[d][1]); }
            }
            bf16_t* o = kvc + ((size_t)((dir * 2 + b) * 6 + h) * 64 + n) * 32768;
#pragma unroll
            for (int et = 0; et < 2; ++et)
#pragma unroll
                for (int d = 0; d < 8; ++d) { u32x2 w; w.x = pk2(acc[d][et][0], acc[d][et][1]); w.y = pk2(acc[d][et][2], acc[d][et][3]);
                    *(u32x2*)(o + (size_t)(32 * wave + 16 * et + i16) * 128 + 16 * d + 4 * g4) = w; }
        }
        if (!has_next) break;
        u = un;
    }
    __syncthreads();
#undef RK_PREFETCH
}
__device__ __forceinline__ void phase_ret_scan(const Params& p, int L, int tid) {
    const int li = L >> 1; const bf16_t* kvc = (const bf16_t*)(p.ws + WS_KVC); bf16_t* st = (bf16_t*)(p.ws + WS_ST);
    for (int task = bidx() * 512 + tid; task < 24 * 4096; task += gridDim.x * 512) {
        const int seq = task >> 12, off = (task & 4095) * 8; const int h = seq % 6, dir = seq / 12;
        const float dec = fast_exp2(log2_gamma(dir ? p.in[I_RDB][li * 6 + h] : p.in[I_RDF][li * 6 + h]) * 128.0f);
        const size_t base = (size_t)seq * 64 * 32768 + off;
        float s[8];
#pragma unroll
        for (int j = 0; j < 8; ++j) s[j] = 0.f;
#pragma unroll 1
        for (int q0 = 0; q0 < 64; q0 += 32) {
            u32x4 kv[32];
#pragma unroll
            for (int i = 0; i < 32; ++i) { const int n = dir ? 63 - (q0 + i) : q0 + i; kv[i] = *(const u32x4*)(kvc + base + (size_t)n * 32768); }
#pragma unroll
            for (int i = 0; i < 32; ++i) { const int n = dir ? 63 - (q0 + i) : q0 + i;
                u32x4 w; w.x = pk2(s[0], s[1]); w.y = pk2(s[2], s[3]); w.z = pk2(s[4], s[5]); w.w = pk2(s[6], s[7]);
                *(u32x4*)(st + base + (size_t)n * 32768) = w;
                s[0] = s[0] * dec + __uint_as_float(kv[i].x << 16); s[1] = s[1] * dec + __uint_as_float(kv[i].x & 0xffff0000u);
                s[2] = s[2] * dec + __uint_as_float(kv[i].y << 16); s[3] = s[3] * dec + __uint_as_float(kv[i].y & 0xffff0000u);
                s[4] = s[4] * dec + __uint_as_float(kv[i].z << 16); s[5] = s[5] * dec + __uint_as_float(kv[i].z & 0xffff0000u);
                s[6] = s[6] * dec + __uint_as_float(kv[i].w << 16); s[7] = s[7] * dec + __uint_as_float(kv[i].w & 0xffff0000u); }
        }
    }
}
__device__ __forceinline__ void phase_ret_out(const Params& p, int L, LAS unsigned char* lds, int tid, int lane, int wave) {
    const int li = L >> 1; const char* proj = (const char*)(p.ws + WS_PROJ); const char* st = (const char*)(p.ws + WS_ST);
    char* cat = (char*)(p.ws + WS_CAT);
    const int i16 = lane & 15, g4 = lane >> 4;
    constexpr int QS = 272, KOFF = 128 * QS, VOFF = 2 * 128 * QS, ROFF = VOFF + 128 * RT_VS;
    LAS float* red = (LAS float*)(lds + ROFF);
    u32x4 sq[4], sk[4];
    const unsigned lo = (unsigned)((tid >> 4) * RET_W * 2 + (tid & 15) * 16);
    const unsigned lv = (unsigned)((tid >> 5) * RET_W * 2 + (tid & 31) * 16);
#define RO_PREFETCH(U) do { const int h_ = (U) % 6, n_ = ((U) / 6) & 63, b_ = (U) / 384; const char* pr_ = proj + ((size_t)b_ * SEQ + n_ * 128) * RET_W * 2; \
        _Pragma("unroll") for (int c = 0; c < 4; ++c) { sq[c] = GLD16(pr_ + (size_t)(32 * c) * RET_W * 2 + h_ * 256, lo); sk[c] = GLD16(pr_ + (size_t)(32 * c) * RET_W * 2 + 1536 + h_ * 256, lo); } } while (0)
    int u = bidx(); if (u >= 768) return;
    RO_PREFETCH(u);
    for (;;) {
        const int h = u % 6, n = (u / 6) & 63, b = u / 384;
        const int un = u + (int)gridDim.x; const bool has_next = un < 768;
        const float lgf = log2_gamma(p.in[I_RDF][li * 6 + h]), lgb = log2_gamma(p.in[I_RDB][li * 6 + h]);
        const size_t row0 = (size_t)b * SEQ + n * 128;
        const char* prow = proj + row0 * RET_W * 2;
        const unsigned lst = (unsigned)(i16 * 256 + g4 * 16);
        u32x4 stf[2][4][2];
#define RO_STATE(dir) do { const char* sp = st + (((size_t)(((dir) * 2 + b) * 6 + h) * 64 + n) * 32768 + (size_t)(32 * wave) * 128) * 2; \
        _Pragma("unroll") for (int ks = 0; ks < 4; ++ks) { stf[dir][ks][0] = GLD16(sp + 64 * ks, lst); stf[dir][ks][1] = GLD16(sp + 16 * 256 + 64 * ks, lst); } } while (0)
        RO_STATE(0);
        __syncthreads();
#pragma unroll
        for (int c = 0; c < 4; ++c) {
            *(LAS u32x4*)(lds + ((tid >> 4) + 32 * c) * QS + (tid & 15) * 16) = sq[c];
            *(LAS u32x4*)(lds + KOFF + ((tid >> 4) + 32 * c) * QS + (tid & 15) * 16) = sk[c]; }
        u32x4 sv[8];
#pragma unroll
        for (int c = 0; c < 8; ++c) sv[c] = GLD16(prow + (size_t)(16 * c) * RET_W * 2 + 3072 + h * 512, lv);
        __syncthreads();
        {
            f32x4 sc[8];
            { bf16x8 qf[4];
#pragma unroll
              for (int ks = 0; ks < 4; ++ks) qf[ks] = *(const LAS bf16x8*)(lds + (16 * wave + i16) * QS + (32 * ks + 8 * g4) * 2);
#pragma unroll
              for (int s8 = 0; s8 < 8; ++s8) { f32x4 a = (f32x4){0.f, 0.f, 0.f, 0.f};
#pragma unroll
                  for (int ks = 0; ks < 4; ++ks) { const bf16x8 kf = *(const LAS bf16x8*)(lds + KOFF + (16 * s8 + i16) * QS + (32 * ks + 8 * g4) * 2); a = mfma16(kf, qf[ks], a); }
                  sc[s8] = a; if (s8 & 1) asm volatile("" ::: "memory"); } }
            { int t = 16 * wave + i16 - 4 * g4; asm volatile("" : "+v"(t));
#pragma unroll
              for (int s8 = 0; s8 < 8; ++s8)
#pragma unroll
                  for (int r = 0; r < 4; ++r) { const int dl = t - (16 * s8 + r);
                      const float dcy = dl >= 0 ? fast_exp2(lgf * (float)dl) : fast_exp2(lgb * (float)(-dl)); sc[s8][r] = sc[s8][r] * dcy; } }
#pragma unroll
            for (int c = 0; c < 8; ++c) *(LAS u32x4*)(lds + VOFF + ((tid >> 5) + 16 * c) * RT_VS + (tid & 31) * 16) = sv[c];
            __syncthreads();
#pragma unroll
            for (int s8 = 0; s8 < 8; ++s8) { u32x2 w; w.x = pk2(sc[s8][0], sc[s8][1]); w.y = pk2(sc[s8][2], sc[s8][3]);
                *(LAS u32x2*)(lds + KOFF + (16 * wave + i16) * QS + (16 * s8 + 4 * g4) * 2) = w; }
            __syncthreads();
        }
        RO_STATE(1);
        f32x4 acc[2][8];
#pragma unroll
        for (int et = 0; et < 2; ++et)
#pragma unroll
            for (int tt = 0; tt < 8; ++tt) acc[et][tt] = (f32x4){0.f, 0.f, 0.f, 0.f};
        { const LAS unsigned char* qb = lds + i16 * QS + (8 * g4) * 2;
#pragma unroll
          for (int dir = 0; dir < 2; ++dir) {
#pragma unroll
            for (int ks = 0; ks < 4; ++ks) {
                const bf16x8 a0 = u4_to_bf8(stf[dir][ks][0]), a1 = u4_to_bf8(stf[dir][ks][1]);
#pragma unroll
                for (int tt = 0; tt < 8; ++tt) { const bf16x8 qf = *(const LAS bf16x8*)(qb + (16 * tt) * QS + 64 * ks);
                    acc[0][tt] = mfma16(a0, qf, acc[0][tt]); acc[1][tt] = mfma16(a1, qf, acc[1][tt]); }
                asm volatile("" ::: "memory");
            }
#pragma unroll
            for (int tt = 0; tt < 8; ++tt) { const float t = (float)(16 * tt + i16);
                const float f = dir == 0 ? fast_exp2(lgf * (t + 1.0f) - lgb * (128.0f - t)) : fast_exp2(lgb * (128.0f - t));
                acc[0][tt] = acc[0][tt] * f; acc[1][tt] = acc[1][tt] * f; }
          } }
        if (has_next) RO_PREFETCH(un);
        const unsigned lg = (unsigned)(i16 * RET_W * 2 + g4 * 8);
        u32x2 grv[8][2];
#pragma unroll
        for (int tt = 0; tt < 8; ++tt) { const char* gbase = prow + (size_t)(16 * tt) * RET_W * 2 + (3072 + h * 256 + 32 * wave) * 2;
            grv[tt][0] = GLD8(gbase, lg); grv[tt][1] = GLD8(gbase + 32, lg); }
        { const LAS unsigned char* vb = lds + VOFF + (4 * g4 + (i16 >> 2)) * RT_VS + (4 * (i16 & 3)) * 2 + 64 * wave;
          const LAS unsigned char* pb = lds + KOFF + i16 * QS + (4 * g4) * 2;
#pragma unroll 1
          for (int ks = 0; ks < 4; ++ks) {
              const bf16x8 v0 = cat4(tr_read(vb + (32 * ks) * RT_VS), tr_read(vb + (32 * ks + 16) * RT_VS));
              const bf16x8 v1 = cat4(tr_read(vb + (32 * ks) * RT_VS + 32), tr_read(vb + (32 * ks + 16) * RT_VS + 32));
#pragma unroll
              for (int tt = 0; tt < 8; ++tt) { const LAS unsigned char* pr = pb + (16 * tt) * QS + 64 * ks;
                  const u32x2 plo = *(const LAS u32x2*)pr, phi = *(const LAS u32x2*)(pr + 32);
                  u32x4 pw; pw.x = plo.x; pw.y = plo.y; pw.z = phi.x; pw.w = phi.y; const bf16x8 pf = u4_to_bf8(pw);
                  acc[0][tt] = mfma16(v0, pf, acc[0][tt]); acc[1][tt] = mfma16(v1, pf, acc[1][tt]); }
          } }
        const float kscale = 0.08838834764831845f;
#pragma unroll
        for (int tt = 0; tt < 8; ++tt) { float ss = 0.f;
#pragma unroll
            for (int et = 0; et < 2; ++et) { acc[et][tt] = acc[et][tt] * kscale; ss += (acc[et][tt][0] * acc[et][tt][0] + acc[et][tt][1] * acc[et][tt][1]) + (acc[et][tt][2] * acc[et][tt][2] + acc[et][tt][3] * acc[et][tt][3]); }
            ss = xadd16(ss); ss = xadd32(ss);
            if (g4 == 0) red[wave * 128 + 16 * tt + i16] = ss; }
        __syncthreads();
        const float* og = p.in[I_ROG] + (size_t)li * 1536 + h * 256 + 32 * wave;
        const f32x4 gn0 = *(const f32x4*)(og + 4 * g4), gn1 = *(const f32x4*)(og + 16 + 4 * g4);
        const unsigned lc = (unsigned)(i16 * DM * 2 + g4 * 8);
#pragma unroll
        for (int tt = 0; tt < 8; ++tt) { const int t = 16 * tt + i16; float tot = 0.f;
#pragma unroll
            for (int w = 0; w < 8; ++w) tot += red[w * 128 + t];
            const float rs = 1.0f / sqrtf(tot * (1.0f / 256.0f) + EPS);
            char* cbase = cat + (row0 + 16 * tt) * DM * 2 + (h * 256 + 32 * wave) * 2;
#pragma unroll
            for (int et = 0; et < 2; ++et) {
                const u32x2 gr = grv[tt][et];
                const f32x4 gn = et ? gn1 : gn0;
                const float y0 = acc[et][tt][0] * rs * gn[0] * silu_f(__uint_as_float(gr.x << 16)), y1 = acc[et][tt][1] * rs * gn[1] * silu_f(__uint_as_float(gr.x & 0xffff0000u));
                const float y2 = acc[et][tt][2] * rs * gn[2] * silu_f(__uint_as_float(gr.y << 16)), y3 = acc[et][tt][3] * rs * gn[3] * silu_f(__uint_as_float(gr.y & 0xffff0000u));
                u32x2 w; w.x = pk2(y0, y1); w.y = pk2(y2, y3);
                *(u32x2*)(cbase + 32 * et + lc) = w; } }
        if (!has_next) break;
        u = un;
    }
#undef RO_PREFETCH
#undef RO_STATE
    __syncthreads();
}

constexpr int NPH = 10;
constexpr int N_STEPS = 2 + DEPTH * NPH + 1;
__global__ void __launch_bounds__(512, 2) mega(Params p0) {
    extern __shared__ __attribute__((aligned(16))) unsigned char lds_raw[];
    LAS unsigned char* lds = (LAS unsigned char*)lds_raw;
    const int tid0 = threadIdx.x;
    const int G = gridDim.x; const int ngw = G * 8;
    volatile LAS unsigned* misc = (volatile LAS unsigned*)(lds + LDS_MISC);
    if (tid0 < 4) misc[tid0] = 0u;
    __syncthreads();
    unsigned* ctl = (unsigned*)(p0.ws + WS_CTL);
    XcdBarrier bar = xcd_barrier_post(ctl + 4096 + (size_t)p0.li * XCD_BAR_WORDS, misc);
    const int lo = p0.lo, hi = p0.hi; bool did = false; int L_ = 0;
    const bool defer_moe = (G >= 64) && (DEFER_MOE != 0);
    const bool merge_rt = (G == 256) && (lo == 0) && (hi == N_STEPS) && (MERGE_RT != 0);
    const bool split_cv = defer_moe && (G == 256) && (SPLIT_CV != 0);
#define STEP(k) if (lo <= (k) && (k) < hi && ((did ? (xcd_barrier(bar), 0) : 0), did = true, true))
#define FRESH() int tid = tid0; asm volatile("" : "+v"(tid)); const int lane = tid & 63, wave = __builtin_amdgcn_readfirstlane(tid >> 6); const int gw = bidx() * 8 + wave; const __attribute__((address_space(4))) Params* kp_ = (const __attribute__((address_space(4))) Params*)__builtin_amdgcn_kernarg_segment_ptr(); asm volatile("" : "+s"(kp_)); Params p; _Pragma("unroll") for (int i_ = 0; i_ < 21; ++i_) p.in[i_] = kp_->in[i_]; p.out = kp_->out; p.ws = kp_->ws; p.lo = 0; p.hi = 0; p.li = 0; p.pad = 0; unsigned char* ws = p.ws; (void)lane; (void)gw; (void)ws; int L = L_; asm volatile("" : "+s"(L)); const bool ret = (L & 1) != 0; const int li = L >> 1; (void)ret; (void)li

    STEP(0) { FRESH(); for (int rep_ = 0; rep_ < (DUP_ON(0) ? 2 : 1); ++rep_) { if (rep_) xcd_barrier(bar); if (PH_ON(0)) phase_convert(p, !defer_moe, split_cv ? 1 : 0, lds, gw, ngw, wave, lane); } if (PH_ON(2)) phase_norm1(p, 0, false, true, gw, ngw, lane); }
    STEP(1) if (PH_ON(1)) { FRESH();
        pg8::Gemm g{(const bf16_t*)(ws + WS_MEMN), (const bf16_t*)(ws + WS_WMKV), 2048, 4096, DM, nullptr};
        pg8::EpiProj E{(bf16_t*)(ws + WS_KVM), 4096, (float*)(ws + WS_PARTM), 32, 0x0F0F0F0Full, nullptr};
        if (split_cv) {
            pg8::DiagOrder S{bidx()};
            pg8::gemm_phase<pg8::EpiProj, pg8::DiagOrder, false>(lds, g, S, E);
            if (bidx() >= 32) phase_convert(p, false, 2, lds, (bidx() - 32) * 8 + wave, 224 * 8, wave, lane);
        } else {
            pg8::StaticOrder S; S.init(2048, 4096, G, bidx());
            for (int rep_ = 0; rep_ < (DUP_ON(1) ? 2 : 1); ++rep_) { if (rep_) xcd_barrier(bar); pg8::gemm_phase<pg8::EpiProj, pg8::StaticOrder, false>(lds, g, S, E); }
        }
    }
#pragma unroll 1
    for (int Lo = 0; Lo < NLAYERS; ++Lo) {
        const int base = 2 + Lo * NPH; const bool ret = (Lo & 1) != 0; L_ = Lo;
        if (Lo > 0) { STEP(base + 0) { FRESH(); if (PH_ON(2)) phase_norm1(p, L, true, true, gw, ngw, lane); if (DUP_ON(2)) { xcd_barrier(bar); phase_norm1(p, L, true, true, gw, ngw, lane); } } }
        STEP(base + 1) if (PH_ON(3)) { FRESH();
            const int N = ret ? RET_W : ATT_W;
            pg8::Gemm g{(const bf16_t*)(ws + WS_H), ret ? (const bf16_t*)(ws + WS_WINR) + (size_t)li * RET_W * DM : (const bf16_t*)(ws + WS_WINA) + (size_t)li * ATT_W * DM, TT, N, DM, nullptr};
            pg8::StaticOrder S; S.init(TT, N, G, bidx());
            pg8::EpiProj E{(bf16_t*)(ws + WS_PROJ), N, (float*)(ws + WS_PART), N >> 7, ret ? 0xF000000000ull : 0xF0FFFFull, (const float*)(ws + WS_RS1)};
            for (int rep_ = 0; rep_ < (DUP_ON(3) ? 2 : 1); ++rep_) { if (rep_) xcd_barrier(bar); pg8::gemm_phase<pg8::EpiProj, pg8::StaticOrder, false>(lds, g, S, E); }
        }
        if (!ret) {
            STEP(base + 2) { FRESH(); if (PH_ON(4)) phase_attn(p, L, true, lds, tid, lane, wave); if (DUP_ON(4)) { xcd_barrier(bar); phase_attn(p, L, true, lds, tid, lane, wave); } }
        } else {
            STEP(base + 2) { FRESH(); if (PH_ON(5)) phase_ret_kv(p, L, lds, tid, lane, wave); if (DUP_ON(5)) { xcd_barrier(bar); phase_ret_kv(p, L, lds, tid, lane, wave); } if (PH_ON(14)) phase_attn(p, L, false, lds, tid, lane, wave); if (DUP_ON(14)) { xcd_barrier(bar); phase_attn(p, L, false, lds, tid, lane, wave); } }
            STEP(base + 3) { FRESH(); for (int rep_ = 0; rep_ < (DUP_ON(6) ? 2 : 1); ++rep_) { if (rep_) xcd_barrier(bar); if (PH_ON(6)) phase_ret_scan(p, L, tid); } }
            STEP(base + 4) { FRESH(); for (int rep_ = 0; rep_ < (DUP_ON(7) ? 2 : 1); ++rep_) { if (rep_) xcd_barrier(bar); if (PH_ON(7)) phase_ret_out(p, L, lds, tid, lane, wave); } }
        }
        STEP(base + 5) if (PH_ON(8)) { FRESH();
            pg8::Gemm g{(const bf16_t*)(ws + WS_CAT), (const bf16_t*)(ws + WS_WOUT) + (size_t)L * DM * DM, TT, DM, DM, nullptr};
            pg8::StaticOrder S; S.init(TT, DM, G, bidx());
            pg8::EpiDelta E{(bf16_t*)(ws + WS_XR), DM, (const bf16_t*)(ws + WS_H)};
            for (int rep_ = 0; rep_ < (DUP_ON(8) ? 2 : 1); ++rep_) { if (rep_) xcd_barrier(bar); pg8::gemm_phase<pg8::EpiDelta, pg8::StaticOrder, false>(lds, g, S, E); }
        }
        STEP(base + 6) { FRESH(); for (int rep_ = 0; rep_ < (DUP_ON(9) ? 2 : 1); ++rep_) { if (rep_) xcd_barrier(bar); if (PH_ON(9)) phase_router(p, L, lds, gw, ngw, tid, lane); }
            if (merge_rt) router_publish(ctl + 8192 + (L * 2 + (bidx() >> 7)) * 64); }
        if (merge_rt ? (lo <= base + 6 && base + 6 < hi) : (lo <= base + 7 && base + 7 < hi && ((did ? (xcd_barrier(bar), 0) : 0), did = true, true))) { FRESH();
            if (merge_rt && bidx() < 32) router_wait(ctl + 8192 + (L * 2 + (bidx() >> 4)) * 64, 128u, ctl + 4096 + XB_TMO);
            for (int rep_ = 0; rep_ < (DUP_ON(10) ? 2 : 1); ++rep_) { if (rep_) xcd_barrier(bar); if (PH_ON(10)) phase_topk(p, lds, tid, lane, wave); }
            if (defer_moe) {
                const int nA = (G == 256) ? 2560 : 0, nB = 24576 - nA;
                if (bidx() >= 32) convert_moe_layer(p, L, 0, nB, (bidx() - 32) * 8 + wave, (G - 32) * 8, lds, wave, lane);
                else if (nA) convert_moe_layer(p, L, nB, 24576, bidx() * 8 + wave, 256, lds, wave, lane);
            } }
        STEP(base + 8) if (PH_ON(11)) { FRESH();
            pg8::Gemm g{(const bf16_t*)(ws + WS_XR), (const bf16_t*)(ws + WS_WGU) + (size_t)L * NEXP * 2048 * DM, NSLOT, 2048, DM, (const int*)(ws + WS_ROWIDX)};
            pg8::MoeOrder S{G, bidx()};
            pg8::EpiSwiglu E{(bf16_t*)(ws + WS_HID), (const float*)(ws + WS_RSLOT)};
            for (int rep_ = 0; rep_ < (DUP_ON(11) ? 2 : 1); ++rep_) { if (rep_) xcd_barrier(bar); pg8::gemm_phase<pg8::EpiSwiglu, pg8::MoeOrder, true, MOE_B_AUX>(lds, g, S, E); }
        }
        STEP(base + 9) if (PH_ON(12)) { FRESH();
            pg8::Gemm g{(const bf16_t*)(ws + WS_HID), (const bf16_t*)(ws + WS_WDN) + (size_t)L * NEXP * DM * FF, NSLOT, DM, FF, nullptr};
            pg8::MoeOrder S{G, bidx()};
            pg8::EpiDown E{(bf16_t*)(ws + WS_Y), (const float*)(ws + WS_GATEV)};
            for (int rep_ = 0; rep_ < (DUP_ON(12) ? 2 : 1); ++rep_) { if (rep_) xcd_barrier(bar); pg8::gemm_phase<pg8::EpiDown, pg8::MoeOrder, false, MOE_B_AUX>(lds, g, S, E); }
        }
    }
    if (DUP_ON(20) && hi > 5) { for (int i_ = 0; i_ < 40; ++i_) xcd_barrier(bar); }
    L_ = 0;
    STEP(2 + DEPTH * NPH) { FRESH(); if (PH_ON(13)) phase_norm1(p, 0, true, false, gw, ngw, lane); }
#undef STEP
}

extern "C" void kernel_launch(void* const* d_in, const int* in_sizes, int n_in, void* d_out, int out_size, void* d_ws, size_t ws_size, hipStream_t stream) {
    static int grid = 0;
    if (grid == 0) {
        if (n_in != 21 || out_size != TT * DM || ws_size < WS_END) { fprintf(stderr, "kernel_launch: unexpected shapes (n_in %d out %d ws %zu)\n", n_in, out_size, ws_size); grid = -1; return; }
        int dev = 0, cus = 0, per_cu = 0;
        if (hipGetDevice(&dev) != hipSuccess || hipDeviceGetAttribute(&cus, hipDeviceAttributeMultiprocessorCount, dev) != hipSuccess) { grid = -1; return; }
        if (hipFuncSetAttribute((const void*)mega, hipFuncAttributeMaxDynamicSharedMemorySize, LDS_BYTES) != hipSuccess) { fprintf(stderr, "kernel_launch: hipFuncSetAttribute failed\n"); grid = -1; return; }
        if (hipOccupancyMaxActiveBlocksPerMultiprocessor(&per_cu, (const void*)mega, 512, LDS_BYTES) != hipSuccess || per_cu < 1) fprintf(stderr, "kernel_launch: occupancy query says %d\n", per_cu);
        (void)hipGetLastError();
        grid = cus;
    }
    if (grid < 0) return;
    (void)hipMemsetAsync((char*)d_ws + WS_CTL, 0, MK_FUSED ? (size_t)65536 : CTL_BYTES, stream);
    Params a{};
    for (int i = 0; i < 21; ++i) a.in[i] = (const float*)d_in[i];
    a.out = (float*)d_out; a.ws = (unsigned char*)d_ws; a.pad = 0;
#if MK_FUSED
    a.lo = 0; a.hi = N_STEPS; a.li = 0;
    hipLaunchKernelGGL(mega, dim3(grid), dim3(512), LDS_BYTES, stream, a);
#else
    int li = 0;
    for (int s = 0; s < N_STEPS; ++s) {
        if (s >= 2 && s < 2 + DEPTH * NPH) { const int L = (s - 2) / NPH, ph = (s - 2) % NPH; if ((L & 1) == 0 && (ph == 3 || ph == 4)) continue; }
        a.lo = s; a.hi = s + 1; a.li = li++;
        hipLaunchKernelGGL(mega, dim3(grid), dim3(512), LDS_BYTES, stream, a);
    }
#endif
}
```

```cpp
#include <hip/hip_runtime.h>
#include <cstdio>
#include <cstdint>

#define LAS __attribute__((address_space(3)))
typedef unsigned short bf16_t;
typedef short bf16x8 __attribute__((ext_vector_type(8)));
typedef short s16x4 __attribute__((ext_vector_type(4)));
typedef float f32x4 __attribute__((ext_vector_type(4)));
typedef float f32x2 __attribute__((ext_vector_type(2)));
typedef unsigned u32x4 __attribute__((ext_vector_type(4)));
typedef unsigned u32x2 __attribute__((ext_vector_type(2)));

#ifndef PHMASK
#define PHMASK 0xFFFFFFFFu
#endif
#ifndef PHMASK2
#define PHMASK2 0xFFFFFFFFu
#endif
#define PH_ON(k) ((((PHMASK) >> (k)) & 1u) && (L_ < 2 || (((PHMASK2) >> (k)) & 1u)))
#ifndef DUPMASK
#define DUPMASK 0u
#endif
#define DUP_ON(k) (((DUPMASK) >> (k)) & 1u)
#ifndef MERGE_RT
#define MERGE_RT 1
#endif
#ifndef MOE_B_AUX
#define MOE_B_AUX 0
#endif
#ifndef SPLIT_CV
#define SPLIT_CV 1
#endif
#ifndef DEFER_MOE
#define DEFER_MOE 1
#endif
#ifndef NLAYERS
#define NLAYERS 4
#endif
#ifndef MK_FUSED
#define MK_FUSED 1
#endif

constexpr int NB = 2, SEQ = 8192, DM = 2048, TT = NB * SEQ, DEPTH = 4;
constexpr int NEXP = 16, FF = 1024, CAP = 1024, NSLOT = NB * NEXP * CAP;
constexpr int ATT_W = 3072, RET_W = 5120, MEML = 256;
constexpr float EPS = 1e-6f;
constexpr float LOG2E = 1.4426950408889634f;
constexpr float QSCALE2 = 0.08838834764831845f * 1.4426950408889634f;

constexpr size_t MiB = (size_t)1 << 20;
constexpr size_t WS_CTL = 0, CTL_BYTES = 1 * MiB;
constexpr size_t WS_WINA = 1 * MiB;
constexpr size_t WS_WINR = 25 * MiB;
constexpr size_t WS_WMKV = 65 * MiB;
constexpr size_t WS_WOUT = 81 * MiB;
constexpr size_t WS_WGU = 113 * MiB;
constexpr size_t WS_WDN = 625 * MiB;
constexpr size_t WS_MEMN = 881 * MiB;
constexpr size_t WS_KVM = 889 * MiB;
constexpr size_t WS_PARTM = 905 * MiB;
constexpr size_t WS_H = 906 * MiB;
constexpr size_t WS_PROJ = 970 * MiB;
constexpr size_t WS_PART = 1130 * MiB;
constexpr size_t WS_CAT = 1140 * MiB;
constexpr size_t WS_KVC = 1204 * MiB;
constexpr size_t WS_ST = 1300 * MiB;
constexpr size_t WS_HID = 1396 * MiB;
constexpr size_t WS_Y = 1460 * MiB;
constexpr size_t WS_AFF = 1588 * MiB;
constexpr size_t WS_ROWIDX = 1589 * MiB;
constexpr size_t WS_GATEV = 1589 * MiB + 256 * 1024;
constexpr size_t WS_RSLOT = 1589 * MiB + 512 * 1024;
constexpr size_t WS_RS1 = 1589 * MiB + 640 * 1024;
constexpr size_t WS_RS2 = 1589 * MiB + 704 * 1024;
constexpr size_t WS_INV = 1590 * MiB;
constexpr size_t WS_XR = 1591 * MiB;
constexpr size_t WS_END = 1655 * MiB;

constexpr int LDS_BYTES = 160 * 1024;
constexpr int LDS_MISC = LDS_BYTES - 256;

__device__ __forceinline__ float bf2f(unsigned short b) { return __uint_as_float(((unsigned)b) << 16); }
typedef __bf16 bf16x2_t __attribute__((ext_vector_type(2)));
__device__ __forceinline__ unsigned pk2(float lo, float hi) { const f32x2 v = {lo, hi}; const bf16x2_t b = __builtin_convertvector(v, bf16x2_t); return __builtin_bit_cast(unsigned, b); }
__device__ __forceinline__ float shx_f(float v, int o, int lane) { return __int_as_float(__builtin_amdgcn_ds_bpermute((lane ^ o) << 2, __float_as_int(v))); }
__device__ __forceinline__ unsigned shup_u(unsigned v, int o, int lane) { return (unsigned)__builtin_amdgcn_ds_bpermute((lane - o) << 2, (int)v); }
#define SHX(v, o) shx_f((v), (o), lane)
__device__ __forceinline__ float xadd16(float x) { const u32x2 r = __builtin_amdgcn_permlane16_swap(__float_as_uint(x), __float_as_uint(x), false, false); return __uint_as_float(r[0]) + __uint_as_float(r[1]); }
__device__ __forceinline__ float xadd32(float x) { const u32x2 r = __builtin_amdgcn_permlane32_swap(__float_as_uint(x), __float_as_uint(x), false, false); return __uint_as_float(r[0]) + __uint_as_float(r[1]); }
__device__ __forceinline__ float xmax16(float x) { const u32x2 r = __builtin_amdgcn_permlane16_swap(__float_as_uint(x), __float_as_uint(x), false, false); return fmaxf(__uint_as_float(r[0]), __uint_as_float(r[1])); }
__device__ __forceinline__ float xmax32(float x) { const u32x2 r = __builtin_amdgcn_permlane32_swap(__float_as_uint(x), __float_as_uint(x), false, false); return fmaxf(__uint_as_float(r[0]), __uint_as_float(r[1])); }
__device__ __forceinline__ float wave_sum(float v, int lane) {
#pragma unroll
    for (int o = 1; o < 64; o <<= 1) v += SHX(v, o);
    return v;
}
__device__ __forceinline__ int bidx() { int b = (int)blockIdx.x; asm volatile("" : "+s"(b)); return b; }
__device__ __forceinline__ float fast_exp2(float x) { return __builtin_amdgcn_exp2f(x); }
__device__ __forceinline__ float silu_f(float x) { return x * __builtin_amdgcn_rcpf(1.0f + __builtin_amdgcn_exp2f(-x * LOG2E)); }
__device__ __forceinline__ s16x4 tr_read(const LAS unsigned char* p) {
    typedef short v4i16_t __attribute__((ext_vector_type(4)));
    return __builtin_bit_cast(s16x4, __builtin_amdgcn_ds_read_tr16_b64_v4i16((LAS v4i16_t*)p));
}
__device__ __forceinline__ bf16x8 cat4(s16x4 lo, s16x4 hi) { bf16x8 r; r[0] = lo[0]; r[1] = lo[1]; r[2] = lo[2]; r[3] = lo[3]; r[4] = hi[0]; r[5] = hi[1]; r[6] = hi[2]; r[7] = hi[3]; return r; }
__device__ __forceinline__ bf16x8 u4_to_bf8(u32x4 w) { return __builtin_bit_cast(bf16x8, w); }
__device__ __forceinline__ f32x4 mfma16(bf16x8 a, bf16x8 b, f32x4 c) { return __builtin_amdgcn_mfma_f32_16x16x32_bf16(a, b, c, 0, 0, 0); }

namespace pg8 {
constexpr int BM = 256, BK = 64, HALF = 128, HTB = HALF * BK * 2, STAGE_BYTES = 8 * HTB, NXCD = 8, WGM = 8;
__host__ __device__ __forceinline__ int lds_byte(int r, int c) { const int st = (r >> 4) * 2 + (c >> 5), rr = r & 15, cc = c & 31, ob = rr * 64 + cc * 2; return st * 1024 + (ob ^ (((ob >> 9) & 1) << 5)); }
__host__ __device__ __forceinline__ void stage_rc(int b, int& R, int& C) { const int st = b / 1024, sb = b % 1024, swz = sb ^ (((sb >> 9) & 1) << 5); R = (st >> 1) * 16 + swz / 64; C = (st & 1) * 32 + (swz % 64) / 2; }
__host__ __device__ __forceinline__ int perm32(int rho) { const int n = rho >> 4, i = rho & 15; return 8 * (i >> 2) + 4 * n + (i & 3); }

struct Unit { int pm, pn; };
struct Gemm { const bf16_t* A; const bf16_t* Bt; int M, N, K; const int* rowidx; };

struct StaticOrder {
    int nM, nN, nwg, G, c;
    __device__ void init(int M, int N, int G_, int c_) { nM = M / BM; nN = N / BM; nwg = nM * nN; G = G_; c = c_; }
    __device__ bool next(int i, Unit& u) const {
        const long L = (long)i * G + c; if (L >= nwg) return false;
        int wgid = (int)L; { const int q = nwg / NXCD, r = nwg % NXCD, xcd = wgid % NXCD, off = wgid / NXCD; wgid = (xcd < r ? xcd * (q + 1) : r * (q + 1) + (xcd - r) * q) + off; }
        const int nig = WGM * nN, gid = wgid / nig, fm = gid * WGM, gsz = (nM - fm) < WGM ? (nM - fm) : WGM;
        u.pm = fm + ((wgid % nig) % gsz); u.pn = (wgid % nig) / gsz; return true;
    }
};
struct DiagOrder {
    int c;
    __device__ bool next(int i, Unit& u) const { if (i != 0 || c >= 32) return false; const int l = c >> 3, j = c & 7; u.pm = 2 * l + (j >> 2); u.pn = 4 * l + (j & 3); return true; }
};
struct MoeOrder {
    int G, c;
    __device__ bool next(int i, Unit& u) const {
        const long v = (long)i * G + c; if (v >= 1024) return false;
        int uu = (int)v;
        if (G == 256) { const int x = c & 7, j = c >> 3; uu = (i * 8 + x) * 32 + j; }
        const int grp = uu >> 5, j = uu & 31, e = grp >> 1, b = grp & 1;
        u.pm = (b * NEXP + e) * 4 + (j >> 3); u.pn = e * 8 + (j & 7); return true;
    }
};

struct EpiProj {
    static constexpr bool PERM = true;
    bf16_t* O; int ldc; float* part; int nh; unsigned long long need; const float* rowscale;
    static constexpr bool HAS_PRE = true;
    __device__ __forceinline__ void pre(const Unit& u, int wr, int fr, f32x4 (&pv)[1]) const {
        const int row0 = u.pm * BM + wr * 64 + fr;
#pragma unroll
        for (int q = 0; q < 4; ++q) pv[0][q] = rowscale ? rowscale[row0 + q * 16] : 1.0f; }
    __device__ __forceinline__ void operator()(const f32x4 (&acc)[2][2][4][2], const Unit& u, int wr, int wc, int fr, int fq, const f32x4 (&pv)[1]) const {
        const int row0 = u.pm * BM + wr * 64 + fr, col0 = u.pn * BM + wc * 32 + 8 * fq;
        const bool nd0 = (need >> (u.pn * 2)) & 1ull, nd1 = (need >> (u.pn * 2 + 1)) & 1ull;
        f32x4 pw; pw[0] = rowscale ? rowscale[row0 + HALF] : 1.0f; pw[1] = rowscale ? rowscale[row0 + HALF + 16] : 1.0f; pw[2] = rowscale ? rowscale[row0 + HALF + 32] : 1.0f; pw[3] = rowscale ? rowscale[row0 + HALF + 48] : 1.0f;
#pragma unroll
        for (int ai = 0; ai < 2; ++ai)
#pragma unroll
            for (int m = 0; m < 4; ++m) { const int row = row0 + ai * HALF + m * 16; bf16_t* rowp = O + (size_t)row * ldc + col0; const float rsc = ai ? pw[m] : pv[0][m];
#pragma unroll
                for (int bj = 0; bj < 2; ++bj) { const f32x4 v0 = acc[ai][bj][m][0] * rsc, v1 = acc[ai][bj][m][1] * rsc;
                    u32x4 w; w.x = pk2(v0[0], v0[1]); w.y = pk2(v0[2], v0[3]); w.z = pk2(v1[0], v1[1]); w.w = pk2(v1[2], v1[3]);
                    *(u32x4*)(rowp + bj * HALF) = w;
                    if (bj ? nd1 : nd0) {
                        float ss = (v0[0] * v0[0] + v0[1] * v0[1]) + (v0[2] * v0[2] + v0[3] * v0[3]) + (v1[0] * v1[0] + v1[1] * v1[1]) + (v1[2] * v1[2] + v1[3] * v1[3]);
                        { const int lane = fq * 16 + fr; ss = xadd16(ss); ss = xadd32(ss); }
                        if (fq == 0) part[((size_t)row * nh + (u.pn * 2 + bj)) * 4 + wc] = ss; } } }
    }
};
struct EpiResid {
    static constexpr bool PERM = false;
    float* X; int ldc;
    __device__ __forceinline__ void operator()(const f32x4 (&acc)[2][2][4][2], const Unit& u, int wr, int wc, int fr, int fq) const {
        const int row0 = u.pm * BM + wr * 64 + fr, col0 = u.pn * BM + wc * 32 + 4 * fq;
#pragma unroll
        for (int ai = 0; ai < 2; ++ai)
#pragma unroll
            for (int m = 0; m < 4; ++m) { float* rowp = X + (size_t)(row0 + ai * HALF + m * 16) * ldc + col0;
#pragma unroll
                for (int bj = 0; bj < 2; ++bj)
#pragma unroll
                    for (int n = 0; n < 2; ++n) { f32x4* q = (f32x4*)(rowp + bj * HALF + n * 16); *q = *q + acc[ai][bj][m][n]; }
                if (m == 3) asm volatile("" ::: "memory"); }
    }
};
struct EpiDelta {
    static constexpr bool PERM = true;
    bf16_t* O; int ldc; const bf16_t* X;
    static constexpr bool HAS_PRE = false;
    __device__ __forceinline__ void pre(const Unit&, int, int, f32x4 (&)[1]) const {}
    __device__ __forceinline__ void operator()(const f32x4 (&acc)[2][2][4][2], const Unit& u, int wr, int wc, int fr, int fq, const f32x4 (&)[1]) const {
        const int row0 = u.pm * BM + wr * 64 + fr, col0 = u.pn * BM + wc * 32 + 8 * fq;
        u32x4 xv[2][4][2];
#pragma unroll
        for (int ai = 0; ai < 2; ++ai)
#pragma unroll
            for (int m = 0; m < 4; ++m)
#pragma unroll
                for (int bj = 0; bj < 2; ++bj) xv[ai][m][bj] = *(const u32x4*)(X + (size_t)(row0 + ai * HALF + m * 16) * ldc + col0 + bj * HALF);
#pragma unroll
        for (int ai = 0; ai < 2; ++ai)
#pragma unroll
            for (int m = 0; m < 4; ++m) { bf16_t* rowp = O + (size_t)(row0 + ai * HALF + m * 16) * ldc + col0;
#pragma unroll
                for (int bj = 0; bj < 2; ++bj) { const f32x4 v0 = acc[ai][bj][m][0], v1 = acc[ai][bj][m][1]; const u32x4 x = xv[ai][m][bj];
                    u32x4 w; w.x = pk2(v0[0] + __uint_as_float(x.x << 16), v0[1] + __uint_as_float(x.x & 0xffff0000u)); w.y = pk2(v0[2] + __uint_as_float(x.y << 16), v0[3] + __uint_as_float(x.y & 0xffff0000u));
                    w.z = pk2(v1[0] + __uint_as_float(x.z << 16), v1[1] + __uint_as_float(x.z & 0xffff0000u)); w.w = pk2(v1[2] + __uint_as_float(x.w << 16), v1[3] + __uint_as_float(x.w & 0xffff0000u));
                    *(u32x4*)(rowp + bj * HALF) = w; } }
    }
};
struct EpiSwiglu {
    static constexpr bool PERM = true;
    bf16_t* O; const float* rss;
    static constexpr bool HAS_PRE = true;
    __device__ __forceinline__ void pre(const Unit& u, int wr, int fr, f32x4 (&pv)[1]) const {
        const int row0 = u.pm * BM + wr * 64 + fr;
#pragma unroll
        for (int q = 0; q < 4; ++q) pv[0][q] = rss[row0 + q * 16]; }
    __device__ __forceinline__ void operator()(const f32x4 (&acc)[2][2][4][2], const Unit& u, int wr, int wc, int fr, int fq, const f32x4 (&pv)[1]) const {
        const int row0 = u.pm * BM + wr * 64 + fr, col0 = (u.pn & 7) * 128 + wc * 32 + 8 * fq;
        f32x4 pw; pw[0] = rss[row0 + HALF]; pw[1] = rss[row0 + HALF + 16]; pw[2] = rss[row0 + HALF + 32]; pw[3] = rss[row0 + HALF + 48];
#pragma unroll
        for (int ai = 0; ai < 2; ++ai)
#pragma unroll
            for (int m = 0; m < 4; ++m) { const float rsc = ai ? pw[m] : pv[0][m];
                const f32x4 g0 = acc[ai][0][m][0] * rsc, g1 = acc[ai][0][m][1] * rsc, u0 = acc[ai][1][m][0] * rsc, u1 = acc[ai][1][m][1] * rsc;
                u32x4 w; w.x = pk2(silu_f(g0[0]) * u0[0], silu_f(g0[1]) * u0[1]); w.y = pk2(silu_f(g0[2]) * u0[2], silu_f(g0[3]) * u0[3]);
                w.z = pk2(silu_f(g1[0]) * u1[0], silu_f(g1[1]) * u1[1]); w.w = pk2(silu_f(g1[2]) * u1[2], silu_f(g1[3]) * u1[3]);
                *(u32x4*)(O + (size_t)(row0 + ai * HALF + m * 16) * FF + col0) = w; }
    }
};
struct EpiDown {
    static constexpr bool PERM = true;
    bf16_t* O; const float* gate;
    static constexpr bool HAS_PRE = true;
    __device__ __forceinline__ void pre(const Unit& u, int wr, int fr, f32x4 (&pv)[1]) const {
        const int row0 = u.pm * BM + wr * 64 + fr;
#pragma unroll
        for (int q = 0; q < 4; ++q) pv[0][q] = gate[row0 + q * 16]; }
    __device__ __forceinline__ void operator()(const f32x4 (&acc)[2][2][4][2], const Unit& u, int wr, int wc, int fr, int fq, const f32x4 (&pv)[1]) const {
        const int row0 = u.pm * BM + wr * 64 + fr, col0 = (u.pn & 7) * BM + wc * 32 + 8 * fq;
        f32x4 pw; pw[0] = gate[row0 + HALF]; pw[1] = gate[row0 + HALF + 16]; pw[2] = gate[row0 + HALF + 32]; pw[3] = gate[row0 + HALF + 48];
#pragma unroll
        for (int ai = 0; ai < 2; ++ai)
#pragma unroll
            for (int m = 0; m < 4; ++m) { const int row = row0 + ai * HALF + m * 16; const float gt = ai ? pw[m] : pv[0][m]; bf16_t* rowp = O + (size_t)row * DM + col0;
#pragma unroll
                for (int bj = 0; bj < 2; ++bj) { const f32x4 v0 = acc[ai][bj][m][0] * gt, v1 = acc[ai][bj][m][1] * gt;
                    u32x4 w; w.x = pk2(v0[0], v0[1]); w.y = pk2(v0[2], v0[3]); w.z = pk2(v1[0], v1[1]); w.w = pk2(v1[2], v1[3]);
                    *(u32x4*)(rowp + bj * HALF) = w; } }
    }
};

template <class Epi, class Sched, bool GATHER, int B_AUX = 0>
__device__ __forceinline__ void gemm_phase(LAS unsigned char* lds, const Gemm g, const Sched& S, const Epi& E) {
    int tid = threadIdx.x; asm volatile("" : "+v"(tid));
    const int wid = __builtin_amdgcn_readfirstlane(tid >> 6), lane = tid & 63, wr = wid >> 2, wc = wid & 3, fr = lane & 15, fq = lane >> 4;
    const int K = g.K, nt = K / BK;
    unsigned voffA[2], voffB[2];
#pragma unroll
    for (int i = 0; i < 2; ++i) { int R, C; stage_rc(tid * 16 + i * 8192, R, C); const int Rb = Epi::PERM ? ((R & ~31) + perm32(R & 31)) : R;
        voffA[i] = (unsigned)(R * K + C) * 2u; voffB[i] = (unsigned)(Rb * K + C) * 2u; }
    const size_t kstep = (size_t)(BK * 2);
    const size_t hstep = (size_t)HALF * K * 2;
    const size_t tstep = 2 * hstep;
    const unsigned ldsw = (unsigned)wid * 1024u;
    const int aoff = lds_byte(wr * 64 + fr, fq * 8), boff = lds_byte(wc * 32 + fr, fq * 8);
    unsigned gA[2][2];
#define PG8_SA(b, h) (((b) * 2 + (h)) * HTB)
#define PG8_SB(b, h) ((4 + (b) * 2 + (h)) * HTB)
#define PG8_STAGE(bufoff, gbase, voff) do { _Pragma("unroll") for (int _i = 0; _i < 2; ++_i) \
        __builtin_amdgcn_global_load_lds((const unsigned*)((const char*)(gbase) + (voff)[_i]), (LAS unsigned*)(lds + (bufoff) + ldsw + _i * 8192), 16, 0, 0); } while (0)
#define PG8_STAGEB(bufoff, gbase, voff) do { _Pragma("unroll") for (int _i = 0; _i < 2; ++_i) \
        __builtin_amdgcn_global_load_lds((const unsigned*)((const char*)(gbase) + (voff)[_i]), (LAS unsigned*)(lds + (bufoff) + ldsw + _i * 8192), 16, 0, B_AUX); } while (0)
#define PG8_ASTAGE(b, h, kp, NX) do { if constexpr (GATHER) { PG8_STAGE(PG8_SA(b, h), kp, gA[h]); } \
        else { PG8_STAGE(PG8_SA(b, h), (kp) + (h) * hstep, voffA); } } while (0)
#define PG8_ROWS(dst, un) do { _Pragma("unroll") for (int _i = 0; _i < 2; ++_i) { int _R, _C; stage_rc(tid * 16 + _i * 8192, _R, _C); _Pragma("unroll") for (int _h = 0; _h < 2; ++_h) \
        dst[_h][_i] = (unsigned)g.rowidx[(un).pm * BM + _h * HALF + _R] * (unsigned)(K * 2) + (unsigned)_C * 2u; } } while (0)
#define PG8_LDA(dst, b, h) do { _Pragma("unroll") for (int m = 0; m < 4; ++m) _Pragma("unroll") for (int k = 0; k < 2; ++k) dst[m][k] = *(const LAS bf16x8*)(lds + PG8_SA(b, h) + aoff + m * 2048 + k * 1024); } while (0)
#define PG8_LDB(dst, b, h) do { _Pragma("unroll") for (int n = 0; n < 2; ++n) _Pragma("unroll") for (int k = 0; k < 2; ++k) dst[n][k] = *(const LAS bf16x8*)(lds + PG8_SB(b, h) + boff + n * 2048 + k * 1024); } while (0)
#define PG8_MMA(ai, bj, At, Bt) do { __builtin_amdgcn_s_setprio(1); _Pragma("unroll") for (int m = 0; m < 4; ++m) _Pragma("unroll") for (int n = 0; n < 2; ++n) _Pragma("unroll") for (int k = 0; k < 2; ++k) \
        acc[ai][bj][m][n] = __builtin_amdgcn_mfma_f32_16x16x32_bf16(Bt[n][k], At[m][k], acc[ai][bj][m][n], 0, 0, 0); __builtin_amdgcn_s_setprio(0); } while (0)
#define PG8_WAIT_V(n) asm volatile("s_waitcnt vmcnt(" #n ")" ::: "memory")
#define PG8_WAIT_L(n) asm volatile("s_waitcnt lgkmcnt(" #n ")" ::: "memory")
#define PG8_BAR __builtin_amdgcn_s_barrier()
#define PG8_SCHED __builtin_amdgcn_sched_barrier(0)
    Unit cur, nxt; int ui = 0;
    if (!S.next(0, cur)) return;
    f32x4 acc[2][2][4][2];
#pragma unroll
    for (int a = 0; a < 2; ++a)
#pragma unroll
        for (int b = 0; b < 2; ++b)
#pragma unroll
            for (int m = 0; m < 4; ++m)
#pragma unroll
                for (int n = 0; n < 2; ++n) acc[a][b][m][n] = (f32x4){0.f, 0.f, 0.f, 0.f};
    bf16x8 At[4][2], B0[2][2], B1[2][2];
    f32x4 pv[1] = {(f32x4){1.f, 1.f, 1.f, 1.f}};
    const char* cA = GATHER ? (const char*)g.A : (const char*)g.A + (size_t)cur.pm * tstep; const char* cB = (const char*)g.Bt + (size_t)cur.pn * tstep;
    if constexpr (GATHER) { PG8_ROWS(gA, cur); }
    PG8_STAGEB(PG8_SB(0, 0), cB, voffB); PG8_STAGEB(PG8_SB(0, 1), cB + hstep, voffB); PG8_ASTAGE(0, 0, cA, false); PG8_ASTAGE(0, 1, cA, false);
    if (wr == 1) PG8_BAR;
    PG8_WAIT_V(2); PG8_BAR;
    PG8_STAGEB(PG8_SB(1, 0), cB + kstep, voffB); PG8_ASTAGE(1, 0, cA + kstep, false); PG8_STAGEB(PG8_SB(1, 1), cB + hstep + kstep, voffB);
    PG8_WAIT_V(6); PG8_BAR;
    for (;;) {
        const bool has_next = S.next(ui + 1, nxt);
        const char* nA = has_next ? (GATHER ? (const char*)g.A : (const char*)g.A + (size_t)nxt.pm * tstep) : cA; const char* nB = has_next ? (const char*)g.Bt + (size_t)nxt.pn * tstep : cB;
        for (int t = 0; t < nt; t += 2) {
            const bool last = (t == nt - 2);
            const char* a1 = cA + (size_t)(t + 1) * kstep;
            const char* a2 = last ? nA : cA + (size_t)(t + 2) * kstep; const char* b2 = last ? nB : cB + (size_t)(t + 2) * kstep;
            const char* a3 = a2 + kstep; const char* b3 = b2 + kstep;
            if constexpr (Epi::HAS_PRE) { if (last) E.pre(cur, wr, fr, pv); }
            PG8_LDB(B0, 0, 0); PG8_LDB(B1, 0, 1); PG8_SCHED; PG8_LDA(At, 0, 0); PG8_ASTAGE(1, 1, a1, false);
            if constexpr (GATHER) { if (last && has_next) { PG8_ROWS(gA, nxt); } }
            PG8_WAIT_V(8); PG8_WAIT_L(0); PG8_BAR; PG8_MMA(0, 0, At, B0); PG8_MMA(0, 1, At, B1); PG8_BAR; PG8_SCHED;
            PG8_LDA(At, 0, 1); PG8_STAGEB(PG8_SB(0, 0), b2, voffB); PG8_STAGEB(PG8_SB(0, 1), b2 + hstep, voffB); PG8_ASTAGE(0, 0, a2, last);
            PG8_WAIT_V(8); PG8_WAIT_L(0); PG8_BAR; PG8_MMA(1, 0, At, B0); PG8_MMA(1, 1, At, B1); PG8_BAR; PG8_SCHED;
            PG8_LDB(B0, 1, 0); PG8_LDB(B1, 1, 1); PG8_SCHED; PG8_LDA(At, 1, 0); PG8_ASTAGE(0, 1, a2, last);
            PG8_WAIT_V(8); PG8_WAIT_L(0); PG8_BAR; PG8_MMA(0, 0, At, B0); PG8_MMA(0, 1, At, B1); PG8_BAR; PG8_SCHED;
            PG8_LDA(At, 1, 1); PG8_STAGEB(PG8_SB(1, 0), b3, voffB); PG8_STAGEB(PG8_SB(1, 1), b3 + hstep, voffB); PG8_ASTAGE(1, 0, a3, last);
            PG8_WAIT_V(8); PG8_WAIT_L(0); PG8_BAR; PG8_MMA(1, 0, At, B0); PG8_MMA(1, 1, At, B1); PG8_BAR; PG8_SCHED;
        }
        if (wr == 0) PG8_BAR;
        E(acc, cur, wr, wc, fr, fq, pv);
        if (DUP_ON(21)) { asm volatile("" ::: "memory"); E(acc, cur, wr, wc, fr, fq, pv); }
        if (!has_next) break;
#pragma unroll
        for (int a = 0; a < 2; ++a)
#pragma unroll
            for (int b = 0; b < 2; ++b)
#pragma unroll
                for (int m = 0; m < 4; ++m)
#pragma unroll
                    for (int n = 0; n < 2; ++n) acc[a][b][m][n] = (f32x4){0.f, 0.f, 0.f, 0.f};
        cur = nxt; cA = nA; cB = nB; ++ui;
        if (wr == 1) PG8_BAR;
    }
    PG8_WAIT_V(0);
    PG8_BAR;
#undef PG8_SA
#undef PG8_SB
#undef PG8_STAGE
#undef PG8_ASTAGE
#undef PG8_STAGEB
#undef PG8_ROWS
#undef PG8_LDA
#undef PG8_LDB
#undef PG8_MMA
#undef PG8_WAIT_V
#undef PG8_WAIT_L
#undef PG8_BAR
#undef PG8_SCHED
}
}

#define XB_TMO      128
#define XB_XCNT(j)  (256  + 64 * (j))
#define XB_XSUB(j)  (1280 + 64 * (j))
#define XB_XGEN(j)  (2304 + 64 * (j))
#define XB_TOP      3328
#define XB_TOPGEN   3392
#define XCD_BAR_WORDS 3456
#define XB_SPIN_CAP (1u << 18)
__device__ __forceinline__ unsigned xb_ld(unsigned* p)              { return __hip_atomic_load(p, __ATOMIC_RELAXED, __HIP_MEMORY_SCOPE_AGENT); }
__device__ __forceinline__ unsigned xb_add(unsigned* p, unsigned v) { return __hip_atomic_fetch_add(p, v, __ATOMIC_RELAXED, __HIP_MEMORY_SCOPE_AGENT); }
__device__ __forceinline__ unsigned xb_xcc_id() { return (unsigned)__builtin_amdgcn_s_getreg((3 << 11) | 20) & 0xFu; }
#define XB_SPIN(cond, bar) do { unsigned _sp = 0; while (cond) { \
    if ((++_sp & 255u) == 0u) { if (xb_ld(&(bar)[XB_TMO])) break; if (_sp > XB_SPIN_CAP) { atomicAdd(&(bar)[XB_TMO], 1u); break; } } } } while (0)
struct XcdBarrier { unsigned* bar; unsigned x; volatile LAS unsigned* st; };
__device__ __forceinline__ XcdBarrier xcd_barrier_post(unsigned* bar, volatile LAS unsigned* st) {
    XcdBarrier b; b.bar = bar; b.x = xb_xcc_id(); b.st = st;
    if (threadIdx.x == 0) (void)xb_add(&bar[XB_XCNT(b.x)], 1u);
    return b;
}
__device__ __forceinline__ void xcd_barrier_complete(unsigned* bar, unsigned x, unsigned& nloc, unsigned& nx) {
    const unsigned G = gridDim.x * gridDim.y * gridDim.z;
    unsigned sum, cnt, mine, sp = 0u;
    for (;;) {
        sum = 0u; cnt = 0u; mine = 0u;
#pragma unroll
        for (unsigned j = 0; j < 16; ++j) { const unsigned c = xb_ld(&bar[XB_XCNT(j)]); sum += c; cnt += (c > 0u) ? 1u : 0u; mine = (j == x) ? c : mine; }
        if (sum == G) break;
        __builtin_amdgcn_s_sleep(1);
        if ((++sp & 255u) == 0u) { if (xb_ld(&bar[XB_TMO])) break; if (sp > XB_SPIN_CAP) { atomicAdd(&bar[XB_TMO], 1u); break; } }
    }
    nloc = mine > 0u ? mine : 1u; nx = cnt > 0u ? cnt : 1u;
}
__device__ __noinline__ void xcd_barrier_impl(unsigned* bar_, unsigned x_, volatile LAS unsigned* st_) {
    XcdBarrier b; b.bar = bar_; b.x = x_; b.st = st_;
    asm volatile("s_waitcnt vmcnt(0)" ::: "memory");
    __syncthreads();
    if (threadIdx.x == 0) {
        unsigned* bar = b.bar;
        __builtin_amdgcn_s_waitcnt(0);
        unsigned nloc = b.st[0], nx = b.st[1];
        if (nloc == 0u) { xcd_barrier_complete(bar, b.x, nloc, nx); b.st[0] = nloc; b.st[1] = nx; }
        const unsigned old = xb_add(&bar[XB_XSUB(b.x)], 1u);
        const unsigned gen = old / nloc;
        if (old + 1u == (gen + 1u) * nloc) {
            __builtin_amdgcn_fence(__ATOMIC_RELEASE, "agent");
            asm volatile("s_waitcnt vmcnt(0)" ::: "memory");
            const unsigned og = xb_add(&bar[XB_TOP], 1u);
            const unsigned tg = og / nx;
            if (og + 1u == (tg + 1u) * nx) xb_add(&bar[XB_TOPGEN], 1u);
            else XB_SPIN(xb_ld(&bar[XB_TOPGEN]) == tg, bar);
            __builtin_amdgcn_fence(__ATOMIC_ACQUIRE, "agent");
            xb_add(&bar[XB_XGEN(b.x)], 1u);
            asm volatile("s_waitcnt vmcnt(0)" ::: "memory");
        } else {
            XB_SPIN(xb_ld(&bar[XB_XGEN(b.x)]) == gen, bar);
            __builtin_amdgcn_fence(__ATOMIC_ACQUIRE, "agent");
            asm volatile("s_waitcnt vmcnt(0)" ::: "memory");
        }
    }
    __syncthreads();
}

__device__ __forceinline__ void xcd_barrier(const XcdBarrier& b) { xcd_barrier_impl(b.bar, b.x, b.st); }

struct Params { const float* in[21]; float* out; unsigned char* ws; int lo, hi, li, pad; };
enum { I_X = 0, I_MEM, I_N1G, I_WINA, I_AQG, I_AKG, I_SINK, I_WINR, I_RDF, I_RDB, I_ROG, I_MNG, I_WMKV, I_CQG, I_CKG, I_WOUT, I_N2G, I_WR, I_WG, I_WU, I_WD };

template <bool NTS = true>
__device__ __forceinline__ void transpose_item(const float* src, int N, int K, bf16_t* dst, int drow0, int k0, int n0, LAS unsigned* scr, int lane, const float* kgain = nullptr) {
    f32x4 v[16];
    const int c4 = (lane & 15) * 4, kr = lane >> 4;
#pragma unroll
    for (int j = 0; j < 16; ++j) v[j] = __builtin_nontemporal_load((const f32x4*)(src + (size_t)(k0 + 4 * j + kr) * N + n0 + c4));
#pragma unroll
    for (int j = 0; j < 16; ++j) { const int k = 4 * j + kr; const float gk = kgain ? kgain[k0 + k] : 1.0f;
        scr[k * 33 + (lane & 15) * 2] = pk2(v[j][0] * gk, v[j][1] * gk); scr[k * 33 + (lane & 15) * 2 + 1] = pk2(v[j][2] * gk, v[j][3] * gk); }
    asm volatile("s_waitcnt lgkmcnt(0)" ::: "memory");
    const LAS unsigned short* sh = (const LAS unsigned short*)scr;
    const int kc = lane & 7;
#pragma unroll
    for (int jj = 0; jj < 8; ++jj) { const int n = (lane >> 3) + 8 * jj;
        unsigned h[8];
#pragma unroll
        for (int e = 0; e < 8; ++e) h[e] = sh[(8 * kc + e) * 66 + n];
        u32x4 w; w.x = h[0] | (h[1] << 16); w.y = h[2] | (h[3] << 16); w.z = h[4] | (h[5] << 16); w.w = h[6] | (h[7] << 16);
        if constexpr (NTS) __builtin_nontemporal_store(w, (u32x4*)(dst + (size_t)(drow0 + n) * K + k0 + 8 * kc)); else *(u32x4*)(dst + (size_t)(drow0 + n) * K + k0 + 8 * kc) = w; }
    asm volatile("s_waitcnt lgkmcnt(0)" ::: "memory");
}
__device__ __forceinline__ void phase_convert(const Params& p, bool moe_too, int part, LAS unsigned char* lds, int gw, int ngw, int wave, int lane) {
    LAS unsigned* scr = (LAS unsigned*)(lds + wave * 8448);
    unsigned char* ws = p.ws;
    constexpr int C0 = 2 * 1536, C1 = C0 + 2 * 2560, C2 = C1 + 4 * 512, C3 = C2 + 4 * 1024, C4 = C3 + 64 * 512, C5 = C4 + 64 * 512, C6 = C5 + 64 * 512;
    const int nj = part == 0 ? (moe_too ? C6 : C3) : (part == 1 ? 1536 + 2048 : C3 - 1536 - 2048);
    for (int j = gw; j < nj; j += ngw) {
        const int it = part == 0 ? j : (part == 1 ? (j < 1536 ? j : C1 + (j - 1536)) : (j < C1 - 1536 ? 1536 + j : C2 + (j - (C1 - 1536))));
        if (it < C0) { const int mat = it / 1536, r = it % 1536, kb = r / 48, nb = r % 48;
            transpose_item(p.in[I_WINA] + (size_t)mat * DM * ATT_W, ATT_W, DM, (bf16_t*)(ws + WS_WINA) + (size_t)mat * ATT_W * DM, 64 * nb, 64 * kb, 64 * nb, scr, lane, p.in[I_N1G] + (size_t)(2 * mat) * DM); }
        else if (it < C1) { const int q = it - C0, mat = q / 2560, r = q % 2560, kb = r / 80, nb = r % 80;
            transpose_item(p.in[I_WINR] + (size_t)mat * DM * RET_W, RET_W, DM, (bf16_t*)(ws + WS_WINR) + (size_t)mat * RET_W * DM, 64 * nb, 64 * kb, 64 * nb, scr, lane, p.in[I_N1G] + (size_t)(2 * mat + 1) * DM); }
        else if (it < C2) { const int q = it - C1, mat = q / 512, r = q % 512, kb = r / 16, nb = r % 16;
            transpose_item(p.in[I_WMKV] + (size_t)mat * DM * 1024, 1024, DM, (bf16_t*)(ws + WS_WMKV) + (size_t)mat * 1024 * DM, 64 * nb, 64 * kb, 64 * nb, scr, lane); }
        else if (it < C3) { const int q = it - C2, mat = q / 1024, r = q % 1024, kb = r / 32, nb = r % 32;
            transpose_item(p.in[I_WOUT] + (size_t)mat * DM * DM, DM, DM, (bf16_t*)(ws + WS_WOUT) + (size_t)mat * DM * DM, 64 * nb, 64 * kb, 64 * nb, scr, lane); }
        else if (it < C5) { const int up = it >= C4; const int q = it - (up ? C4 : C3), mat = q / 512, r = q % 512, kb = r / 16, nb = r % 16;
            const int n0 = 64 * nb, drow0 = 256 * (n0 >> 7) + 128 * up + (n0 & 127);
            transpose_item(p.in[up ? I_WU : I_WG] + (size_t)mat * DM * FF, FF, DM, (bf16_t*)(ws + WS_WGU) + (size_t)mat * 2048 * DM, drow0, 64 * kb, n0, scr, lane, p.in[I_N2G] + (size_t)(mat >> 4) * DM); }
        else { const int q = it - C5, mat = q / 512, r = q % 512, kb = r / 32, nb = r % 32;
            transpose_item(p.in[I_WD] + (size_t)mat * FF * DM, DM, FF, (bf16_t*)(ws + WS_WDN) + (size_t)mat * DM * FF, 64 * nb, 64 * kb, 64 * nb, scr, lane); }
    }
    bf16_t* memn = (bf16_t*)(ws + WS_MEMN);
    for (int r = gw; r < (part == 2 ? 0 : 4 * 512); r += ngw) { const int l = r >> 9, m = r & 511;
        const float* xr = p.in[I_MEM] + (size_t)m * DM; const float* gn = p.in[I_MNG] + l * DM;
        f32x4 v[8]; float ss = 0.f;
#pragma unroll
        for (int j = 0; j < 8; ++j) { v[j] = *(const f32x4*)(xr + 256 * j + 4 * lane); ss += (v[j][0] * v[j][0] + v[j][1] * v[j][1]) + (v[j][2] * v[j][2] + v[j][3] * v[j][3]); }
        const float rs = 1.0f / sqrtf(wave_sum(ss, lane) * (1.0f / DM) + EPS);
#pragma unroll
        for (int j = 0; j < 8; ++j) { const f32x4 gg = *(const f32x4*)(gn + 256 * j + 4 * lane); u32x2 w; w.x = pk2(v[j][0] * rs * gg[0], v[j][1] * rs * gg[1]); w.y = pk2(v[j][2] * rs * gg[2], v[j][3] * rs * gg[3]);
            *(u32x2*)(memn + (size_t)r * DM + 256 * j + 4 * lane) = w; }
    }
}

__device__ __forceinline__ void convert_moe_layer(const Params& p, int L, int i0, int i1, int w, int nw, LAS unsigned char* lds, int wave, int lane) {
    LAS unsigned* scr = (LAS unsigned*)(lds + wave * 8448);
    unsigned char* ws = p.ws;
    for (int i = i0 + w; i < i1; i += nw) {
        if (i < 16384) { const int up = i >= 8192; const int q = i - up * 8192, mat = L * NEXP + q / 512, r = q % 512, kb = r / 16, nb = r % 16;
            const int n0 = 64 * nb, drow0 = 256 * (n0 >> 7) + 128 * up + (n0 & 127);
            transpose_item<false>(p.in[up ? I_WU : I_WG] + (size_t)mat * DM * FF, FF, DM, (bf16_t*)(ws + WS_WGU) + (size_t)mat * 2048 * DM, drow0, 64 * kb, n0, scr, lane, p.in[I_N2G] + (size_t)L * DM); }
        else { const int q = i - 16384, mat = L * NEXP + q / 512, r = q % 512, kb = r / 32, nb = r % 32;
            transpose_item(p.in[I_WD] + (size_t)mat * FF * DM, DM, FF, (bf16_t*)(ws + WS_WDN) + (size_t)mat * DM * FF, 64 * nb, 64 * kb, 64 * nb, scr, lane); }
    }
}

__device__ __forceinline__ void addrow_bf16(f32x4 (&v)[8], const u32x2 (&w)[8]) {
#pragma unroll
    for (int j = 0; j < 8; ++j) { v[j][0] += __uint_as_float(w[j].x << 16); v[j][1] += __uint_as_float(w[j].x & 0xffff0000u); v[j][2] += __uint_as_float(w[j].y << 16); v[j][3] += __uint_as_float(w[j].y & 0xffff0000u); }
}
__device__ __forceinline__ void combine_row(f32x4 (&v)[8], int iv, int b, const bf16_t* Y, int lane) {
    unsigned mask = (unsigned)__builtin_amdgcn_readfirstlane((int)(__ballot(iv >= 0) & 0xffffull));
    while (mask) {
        const int e0 = __builtin_ctz(mask); mask &= mask - 1u;
        const int c0 = __builtin_amdgcn_readlane(iv, e0);
        const bool two = mask != 0u;
        const int e1 = two ? __builtin_ctz(mask) : e0; if (two) mask &= mask - 1u;
        const int c1 = __builtin_amdgcn_readlane(iv, e1);
        const bf16_t* y0 = Y + (size_t)((b * NEXP + e0) * CAP + c0) * DM + 4 * lane;
        const bf16_t* y1 = Y + (size_t)((b * NEXP + e1) * CAP + c1) * DM + 4 * lane;
        u32x2 w0[8], w1[8];
#pragma unroll
        for (int j = 0; j < 8; ++j) { w0[j] = __builtin_nontemporal_load((const u32x2*)(y0 + 256 * j)); w1[j] = __builtin_nontemporal_load((const u32x2*)(y1 + 256 * j)); }
        addrow_bf16(v, w0);
        if (two) addrow_bf16(v, w1);
    }
}
__device__ __forceinline__ void xrow_finish(const f32x4 (&v)[8], int t, bool fin, float* outp, bf16_t* XB, float* rs1, int lane) {
    if (fin) {
#pragma unroll
        for (int j = 0; j < 8; ++j) __builtin_nontemporal_store(v[j], (f32x4*)(outp + (size_t)t * DM + 256 * j + 4 * lane));
    } else {
        float ss = 0.f;
#pragma unroll
        for (int j = 0; j < 8; ++j) { ss += (v[j][0] * v[j][0] + v[j][1] * v[j][1]) + (v[j][2] * v[j][2] + v[j][3] * v[j][3]);
            u32x2 w; w.x = pk2(v[j][0], v[j][1]); w.y = pk2(v[j][2], v[j][3]); *(u32x2*)(XB + (size_t)t * DM + 256 * j + 4 * lane) = w; }
        const float rs = 1.0f / sqrtf(wave_sum(ss, lane) * (1.0f / DM) + EPS);
        if (lane == 0) rs1[t] = rs;
    }
}
__device__ __forceinline__ void phase_norm1(const Params& p, int L, bool combine, bool do_norm, int gw, int ngw, int lane) {
    const int* inv = (const int*)(p.ws + WS_INV);
    const bf16_t* Y = (const bf16_t*)(p.ws + WS_Y); const bf16_t* XR = (const bf16_t*)(p.ws + WS_XR);
    bf16_t* XB = (bf16_t*)(p.ws + WS_H); float* rs1 = (float*)(p.ws + WS_RS1);
    for (int t = gw; t < TT; t += 2 * ngw) {
        const int t1 = t + ngw; const bool has1 = t1 < TT; const int t1c = has1 ? t1 : t;
        f32x4 v0[8], v1[8];
        if (!combine) {
#pragma unroll
            for (int j = 0; j < 8; ++j) { v0[j] = *(const f32x4*)(p.in[I_X] + (size_t)t * DM + 256 * j + 4 * lane); v1[j] = *(const f32x4*)(p.in[I_X] + (size_t)t1c * DM + 256 * j + 4 * lane); }
        } else {
            const int iv0 = inv[(size_t)t * 16 + (lane & 15)], iv1 = inv[(size_t)t1c * 16 + (lane & 15)];
            { u32x2 d0[8], d1[8];
#pragma unroll
              for (int j = 0; j < 8; ++j) { d0[j] = __builtin_nontemporal_load((const u32x2*)(XR + (size_t)t * DM + 256 * j + 4 * lane)); d1[j] = __builtin_nontemporal_load((const u32x2*)(XR + (size_t)t1c * DM + 256 * j + 4 * lane)); }
#pragma unroll
              for (int j = 0; j < 8; ++j) { v0[j] = (f32x4){0.f, 0.f, 0.f, 0.f}; v1[j] = (f32x4){0.f, 0.f, 0.f, 0.f}; }
              addrow_bf16(v0, d0); addrow_bf16(v1, d1); }
            combine_row(v0, iv0, t >> 13, Y, lane);
            combine_row(v1, iv1, t1c >> 13, Y, lane);
        }
        xrow_finish(v0, t, !do_norm, p.out, XB, rs1, lane);
        if (has1) xrow_finish(v1, t1, !do_norm, p.out, XB, rs1, lane);
    }
}

constexpr int RW_STRIDE = 4112, RW_LO = 16 * RW_STRIDE, RW_XCH = 2 * 16 * RW_STRIDE;
__device__ __forceinline__ void phase_router(const Params& p, int L, LAS unsigned char* lds, int gw, int ngw, int tid, int lane) {
    const int wave = __builtin_amdgcn_readfirstlane(tid >> 6);
    const float* wr = p.in[I_WR] + (size_t)L * DM * NEXP; const float* gn = p.in[I_N2G] + (size_t)L * DM;
    const bf16_t* XR = (const bf16_t*)(p.ws + WS_XR); float* rs2 = (float*)(p.ws + WS_RS2);
    float* aff = (float*)(p.ws + WS_AFF);
    const int i16 = lane & 15, g4 = lane >> 4, half = wave >> 2;
    LAS float* xch = (LAS float*)(lds + RW_XCH) + ((wave & 3) * 64 + lane) * 5;
    u32x4 xa[16];
#define RT_LOAD(dst, T0_, c0) do { int T_ = (T0_) + (wave & 3); T_ = T_ < TT / 16 ? T_ : TT / 16 - 1; const size_t ro_ = (size_t)(16 * T_ + i16) * DM + 1024 * half + 8 * g4; \
        _Pragma("unroll") for (int i = 0; i < 16; ++i) dst[i] = *(const u32x4*)(XR + ro_ + 32 * ((c0) + i)); } while (0)
#define RT_STEP(src, c0) do { _Pragma("unroll") for (int i = 0; i < 16; ++i) { float v[8]; \
            v[0] = __uint_as_float(src[i].x << 16); v[1] = __uint_as_float(src[i].x & 0xffff0000u); v[2] = __uint_as_float(src[i].y << 16); v[3] = __uint_as_float(src[i].y & 0xffff0000u); \
            v[4] = __uint_as_float(src[i].z << 16); v[5] = __uint_as_float(src[i].z & 0xffff0000u); v[6] = __uint_as_float(src[i].w << 16); v[7] = __uint_as_float(src[i].w & 0xffff0000u); \
            ss += ((v[0] * v[0] + v[1] * v[1]) + (v[2] * v[2] + v[3] * v[3])) + ((v[4] * v[4] + v[5] * v[5]) + (v[6] * v[6] + v[7] * v[7])); \
            const bf16x8 bh = *(const LAS bf16x8*)(wb + 64 * ((c0) + i)), bl = *(const LAS bf16x8*)(wb + RW_LO + 64 * ((c0) + i)); \
            acc = mfma16(u4_to_bf8(src[i]), bh, acc); acc = mfma16(u4_to_bf8(src[i]), bl, acc); } } while (0)
    int T0 = bidx() * 4;
    if (T0 < TT / 16) RT_LOAD(xa, T0, 0);
    for (int c = tid; c < DM; c += 512) { const float g = gn[c];
#pragma unroll
        for (int q = 0; q < 4; ++q) { const f32x4 w = *(const f32x4*)(wr + (size_t)c * 16 + 4 * q);
#pragma unroll
            for (int i = 0; i < 4; ++i) { const float val = w[i] * g; const unsigned hi = pk2(val, 0.f) & 0xffffu; const unsigned lo = pk2(val - __uint_as_float(hi << 16), 0.f) & 0xffffu;
                *(LAS unsigned short*)(lds + (4 * q + i) * RW_STRIDE + 2 * c) = (unsigned short)hi; *(LAS unsigned short*)(lds + RW_LO + (4 * q + i) * RW_STRIDE + 2 * c) = (unsigned short)lo; } }
    }
    __syncthreads();
    for (; T0 < TT / 16; T0 += (int)gridDim.x * 4) {
        int T = T0 + (wave & 3); const bool tile_ok = T < TT / 16; T = tile_ok ? T : TT / 16 - 1;
        const LAS unsigned char* wb = lds + i16 * RW_STRIDE + (1024 * half + 8 * g4) * 2;
        f32x4 acc = (f32x4){0.f, 0.f, 0.f, 0.f}; float ss = 0.f;
        { u32x4 xb[16];
          RT_LOAD(xb, T0, 16);
          RT_STEP(xa, 0);
          if (T0 + (int)gridDim.x * 4 < TT / 16) RT_LOAD(xa, T0 + (int)gridDim.x * 4, 0);
          RT_STEP(xb, 16); }
        ss = xadd16(ss); ss = xadd32(ss);
        if (half == 1) { xch[0] = acc[0]; xch[1] = acc[1]; xch[2] = acc[2]; xch[3] = acc[3]; xch[4] = ss; }
        __syncthreads();
        if (half == 0) {
            acc[0] += xch[0]; acc[1] += xch[1]; acc[2] += xch[2]; acc[3] += xch[3]; ss += xch[4];
            const float rs = 1.0f / sqrtf(ss * (1.0f / DM) + EPS);
            if (tile_ok && g4 == 0) __hip_atomic_store(rs2 + 16 * T + i16, rs, __ATOMIC_RELAXED, __HIP_MEMORY_SCOPE_AGENT);
#pragma unroll
            for (int r = 0; r < 4; ++r) {
                const float rst = __int_as_float(__builtin_amdgcn_ds_bpermute((4 * g4 + r) << 2, __float_as_int(rs)));
                const float lg = acc[r] * rst;
                float mx = lg; mx = fmaxf(mx, SHX(mx, 1)); mx = fmaxf(mx, SHX(mx, 2)); mx = fmaxf(mx, SHX(mx, 4)); mx = fmaxf(mx, SHX(mx, 8));
                const float pe = expf(lg - mx);
                float sm = pe; sm += SHX(sm, 1); sm += SHX(sm, 2); sm += SHX(sm, 4); sm += SHX(sm, 8);
                const int t = 16 * T + 4 * g4 + r;
                if (tile_ok) __hip_atomic_store(aff + ((size_t)((t >> 13) * NEXP + i16)) * SEQ + (t & (SEQ - 1)), pe / sm, __ATOMIC_RELAXED, __HIP_MEMORY_SCOPE_AGENT);
            }
        }
        __syncthreads();
    }
    __syncthreads();
}

__device__ __forceinline__ void router_publish(unsigned* cnt) {
    asm volatile("s_waitcnt vmcnt(0)" ::: "memory");
    __syncthreads();
    if (threadIdx.x == 0) __hip_atomic_fetch_add(cnt, 1u, __ATOMIC_RELAXED, __HIP_MEMORY_SCOPE_AGENT);
}
__device__ __forceinline__ void router_wait(unsigned* cnt, unsigned need, unsigned* tmo) {
    if (threadIdx.x < 64) {
        unsigned sp = 0;
        while ((unsigned)__builtin_amdgcn_readfirstlane((int)__hip_atomic_load(cnt, __ATOMIC_RELAXED, __HIP_MEMORY_SCOPE_AGENT)) < need) {
            __builtin_amdgcn_s_sleep(2);
            if ((++sp & 255u) == 0u) { if (__hip_atomic_load(tmo, __ATOMIC_RELAXED, __HIP_MEMORY_SCOPE_AGENT)) break; if (sp > (1u << 18)) { if (threadIdx.x == 0) atomicAdd(tmo, 1u); break; } } }
        __builtin_amdgcn_fence(__ATOMIC_ACQUIRE, "agent");
        asm volatile("s_waitcnt vmcnt(0)" ::: "memory");
    }
    __syncthreads();
}

__device__ __forceinline__ void phase_topk(const Params& p, LAS unsigned char* lds, int tid, int lane, int wave) {
    LAS unsigned* hist = (LAS unsigned*)lds;
    LAS unsigned* shw = (LAS unsigned*)(lds + 1024);
    const float* aff = (const float*)(p.ws + WS_AFF);
    int* rowidx = (int*)(p.ws + WS_ROWIDX); float* gatev = (float*)(p.ws + WS_GATEV); int* inv = (int*)(p.ws + WS_INV);
    const float* rs2 = (const float*)(p.ws + WS_RS2); float* rslot = (float*)(p.ws + WS_RSLOT);
    for (int u = bidx(); u < NB * NEXP; u += gridDim.x) {
        const int b = u >> 4, e = u & 15;
        unsigned key[16];
#pragma unroll
        for (int q = 0; q < 4; ++q) { const u32x4 w = *(const u32x4*)(aff + (size_t)u * SEQ + 16 * tid + 4 * q); key[4 * q] = w.x; key[4 * q + 1] = w.y; key[4 * q + 2] = w.z; key[4 * q + 3] = w.w; }
        unsigned prefix = 0u, mask = 0u, kk = CAP;
#pragma unroll 1
        for (int pass = 0; pass < 4; ++pass) {
            const int shift = 24 - 8 * pass;
            if (tid < 256) hist[tid] = 0u;
            __syncthreads();
#pragma unroll
            for (int i = 0; i < 16; ++i) if ((key[i] & mask) == prefix) __hip_atomic_fetch_add(&hist[(key[i] >> shift) & 255u], 1u, __ATOMIC_RELAXED, __HIP_MEMORY_SCOPE_WORKGROUP);
            __syncthreads();
            if (wave == 0) {
                const unsigned c0 = hist[255 - 4 * lane], c1 = hist[254 - 4 * lane], c2 = hist[253 - 4 * lane], c3 = hist[252 - 4 * lane];
                const unsigned tot = c0 + c1 + c2 + c3; unsigned incl = tot;
#pragma unroll
                for (int o = 1; o < 64; o <<= 1) { const unsigned y = shup_u(incl, o, lane); if (lane >= o) incl += y; }
                const unsigned excl = incl - tot;
                if (excl < kk && kk <= incl) { unsigned rem = kk - excl, bin;
                    if (rem <= c0) bin = 255 - 4 * lane; else { rem -= c0; if (rem <= c1) bin = 254 - 4 * lane; else { rem -= c1; if (rem <= c2) bin = 253 - 4 * lane; else { rem -= c2; bin = 252 - 4 * lane; } } }
                    shw[0] = bin; shw[1] = rem; }
            }
            __syncthreads();
            prefix |= shw[0] << shift; mask |= 255u << shift; kk = shw[1];
        }
        unsigned ne = 0;
#pragma unroll
        for (int i = 0; i < 16; ++i) ne += (key[i] == prefix) ? 1u : 0u;
        unsigned incl = ne;
#pragma unroll
        for (int o = 1; o < 64; o <<= 1) { const unsigned y = shup_u(incl, o, lane); if (lane >= o) incl += y; }
        if (lane == 63) shw[8 + wave] = incl;
        __syncthreads();
        unsigned eqbase = incl - ne;
#pragma unroll
        for (int w = 0; w < 8; ++w) eqbase += (w < wave) ? shw[8 + w] : 0u;
        unsigned selm = 0u, ns = 0u, er = eqbase;
#pragma unroll
        for (int i = 0; i < 16; ++i) { const bool gt = key[i] > prefix, eq = key[i] == prefix; const bool sel = gt || (eq && er < kk); er += eq ? 1u : 0u; selm |= sel ? (1u << i) : 0u; ns += sel ? 1u : 0u; }
        unsigned incl2 = ns;
#pragma unroll
        for (int o = 1; o < 64; o <<= 1) { const unsigned y = shup_u(incl2, o, lane); if (lane >= o) incl2 += y; }
        if (lane == 63) shw[16 + wave] = incl2;
        __syncthreads();
        unsigned cpos = incl2 - ns;
#pragma unroll
        for (int w = 0; w < 8; ++w) cpos += (w < wave) ? shw[16 + w] : 0u;
#pragma unroll
        for (int i = 0; i < 16; ++i) { const int tok = 16 * tid + i; const bool sel = (selm >> i) & 1u;
            if (sel) { rowidx[u * CAP + cpos] = b * SEQ + tok; gatev[u * CAP + cpos] = __uint_as_float(key[i]); rslot[u * CAP + cpos] = rs2[b * SEQ + tok]; }
            inv[((size_t)(b * SEQ + tok)) * 16 + e] = sel ? (int)cpos : -1;
            cpos += sel ? 1u : 0u; }
        __syncthreads();
    }
}

constexpr int AT_KS = 272, AT_VS = 288, AT_VOFF = 128 * AT_KS, AT_BUF = AT_VOFF + 128 * AT_VS;
__device__ __forceinline__ int xcd_vcu() { const int G = (int)gridDim.x, c = bidx(); return (G % 8 == 0) ? (c % 8) * (G / 8) + c / 8 : c; }
__device__ __forceinline__ float alibi_slope(int h) { return (h < 8) ? exp2f(-(float)(h + 1)) : exp2f(-0.5f * (float)(2 * (h - 8) + 1)); }
struct AttnU { int qrow0, krow_base, jb_lo, jb_hi, nq, qcol, kcol, vcol, ocol; float nslope2, m0; };
template <int MODE>
__device__ __forceinline__ void phase_attn_mode(const Params& p, int L, LAS unsigned char* lds, int tid, int lane, int wave) {
    const int li = L >> 1; const bool ret = (L & 1) != 0;
    const bf16_t* proj = (const bf16_t*)(p.ws + WS_PROJ); const int ldq = ret ? RET_W : ATT_W; const int qnh = ldq >> 7;
    const float* qpart = (const float*)(p.ws + WS_PART);
    const bf16_t* kvsrc = MODE == 0 ? proj : (const bf16_t*)(p.ws + WS_KVM); const int ldkv = MODE == 0 ? ldq : 4096;
    const float* kpart = MODE == 0 ? qpart : (const float*)(p.ws + WS_PARTM); const int knh = MODE == 0 ? qnh : 32;
    const float* qgain = MODE == 0 ? p.in[I_AQG] + li * 128 : p.in[I_CQG] + L * 128;
    const float* kgain = MODE == 0 ? p.in[I_AKG] + li * 128 : p.in[I_CKG] + L * 128;
    bf16_t* cat = (bf16_t*)(p.ws + WS_CAT);
    const int NU = MODE == 0 ? 1536 : 512, G = gridDim.x;
    const int i16 = lane & 15, g4 = lane >> 4;
    auto decode = [&](int u, AttnU& a) {
        if (MODE == 0) { const int hq = u % 12, n = (u / 12) & 63, b = u / 768, hk = hq / 3;
            a.qrow0 = b * SEQ + n * 128; a.krow_base = b * SEQ; a.jb_lo = n > 0 ? n - 1 : 0; a.jb_hi = n < 63 ? n + 1 : 63; a.nq = n;
            a.qcol = hq * 128; a.kcol = 1536 + hk * 128; a.vcol = 2048 + hk * 128; a.ocol = hq * 128;
            a.nslope2 = -alibi_slope(hq) * LOG2E; a.m0 = p.in[I_SINK][li * 12 + hq] * LOG2E; }
        else { const int hd = u & 3, n = (u >> 2) & 63, b = u >> 8;
            a.qrow0 = b * SEQ + n * 128; a.krow_base = L * 512 + b * MEML; a.jb_lo = 0; a.jb_hi = 1; a.nq = n;
            a.qcol = (ret ? 4608 : 2560) + hd * 128; a.kcol = L * 1024 + hd * 128; a.vcol = L * 1024 + 512 + hd * 128; a.ocol = 1536 + hd * 128;
            a.nslope2 = 0.f; a.m0 = -1e30f; }
    };
    u32x4 kraw[4], vraw[4]; f32x4 kpp[4];
    const unsigned lrow = (unsigned)(tid >> 4), lch = (unsigned)(tid & 15);
#define AT_PREFETCH(A, JB) do { const size_t kr0_ = (size_t)((A).krow_base + (JB) * 128); \
        _Pragma("unroll") for (int c = 0; c < 4; ++c) { const size_t kr_ = kr0_ + lrow + 32 * c; \
            kraw[c] = *(const u32x4*)(kvsrc + kr_ * ldkv + (A).kcol + 8 * lch); vraw[c] = *(const u32x4*)(kvsrc + kr_ * ldkv + (A).vcol + 8 * lch); \
            kpp[c] = *(const f32x4*)(kpart + (kr_ * knh + ((A).kcol >> 7)) * 4); } } while (0)
    int u = xcd_vcu(); if (u >= NU) return;
    AttnU cu, nu_; decode(u, cu);
    AT_PREFETCH(cu, cu.jb_lo);
    const f32x4 kga = *(const f32x4*)(kgain + 8 * lch), kgb = *(const f32x4*)(kgain + 8 * lch + 4);
    int bsel = 0;
    for (;;) {
        bf16x8 Qf[4];
        { const int t = cu.qrow0 + 16 * wave + i16; const f32x4 pp = *(const f32x4*)(qpart + ((size_t)t * qnh + (cu.qcol >> 7)) * 4);
          const float rq = __builtin_amdgcn_rsqf(((pp[0] + pp[1]) + (pp[2] + pp[3])) * (1.0f / 128.0f) + EPS) * QSCALE2;
#pragma unroll
          for (int ks = 0; ks < 4; ++ks) { const u32x4 raw = *(const u32x4*)(proj + (size_t)t * ldq + cu.qcol + 32 * ks + 8 * g4);
              const f32x4 ga = *(const f32x4*)(qgain + 32 * ks + 8 * g4), gb = *(const f32x4*)(qgain + 32 * ks + 8 * g4 + 4);
              u32x4 w; w.x = pk2(__uint_as_float(raw.x << 16) * rq * ga[0], __uint_as_float(raw.x & 0xffff0000u) * rq * ga[1]);
              w.y = pk2(__uint_as_float(raw.y << 16) * rq * ga[2], __uint_as_float(raw.y & 0xffff0000u) * rq * ga[3]);
              w.z = pk2(__uint_as_float(raw.z << 16) * rq * gb[0], __uint_as_float(raw.z & 0xffff0000u) * rq * gb[1]);
              w.w = pk2(__uint_as_float(raw.w << 16) * rq * gb[2], __uint_as_float(raw.w & 0xffff0000u) * rq * gb[3]);
              Qf[ks] = u4_to_bf8(w); } }
        f32x4 O[8];
#pragma unroll
        for (int d = 0; d < 8; ++d) O[d] = (f32x4){0.f, 0.f, 0.f, 0.f};
        float mrun = cu.m0, lrun = (MODE == 0 && g4 == 0) ? 1.0f : 0.0f;
        const int tq = cu.nq * 128 + 16 * wave + i16;
        const int un = u + G; const bool has_next = un < NU;
        if (has_next) decode(un, nu_);
        for (int jb = cu.jb_lo; jb <= cu.jb_hi; ++jb) {
            LAS unsigned char* ldb = lds + bsel * AT_BUF; bsel ^= 1;
#pragma unroll
            for (int c = 0; c < 4; ++c) { const float rk = __builtin_amdgcn_rsqf(((kpp[c][0] + kpp[c][1]) + (kpp[c][2] + kpp[c][3])) * (1.0f / 128.0f) + EPS);
                const u32x4 raw = kraw[c];
                u32x4 w; w.x = pk2(__uint_as_float(raw.x << 16) * rk * kga[0], __uint_as_float(raw.x & 0xffff0000u) * rk * kga[1]);
                w.y = pk2(__uint_as_float(raw.y << 16) * rk * kga[2], __uint_as_float(raw.y & 0xffff0000u) * rk * kga[3]);
                w.z = pk2(__uint_as_float(raw.z << 16) * rk * kgb[0], __uint_as_float(raw.z & 0xffff0000u) * rk * kgb[1]);
                w.w = pk2(__uint_as_float(raw.w << 16) * rk * kgb[2], __uint_as_float(raw.w & 0xffff0000u) * rk * kgb[3]);
                *(LAS u32x4*)(ldb + (lrow + 32 * c) * AT_KS + lch * 16) = w;
                *(LAS u32x4*)(ldb + AT_VOFF + (lrow + 32 * c) * AT_VS + lch * 16) = vraw[c]; }
            __syncthreads();
            if (jb < cu.jb_hi) { AT_PREFETCH(cu, jb + 1); } else if (has_next) { AT_PREFETCH(nu_, nu_.jb_lo); }
            const unsigned actm = (MODE == 1 || jb == cu.nq) ? 0xffu : (jb < cu.nq ? (0xffu << wave) & 0xffu : (0xffu >> (7 - wave)));
            f32x4 sc[8];
            float mx = -1e30f;
            const float fb = (float)(tq - jb * 128 - 4 * g4);
#pragma unroll
            for (int kt = 0; kt < 8; ++kt) {
                if ((actm >> kt) & 1u) { f32x4 a = (f32x4){0.f, 0.f, 0.f, 0.f};
#pragma unroll
                    for (int ks = 0; ks < 4; ++ks) { const bf16x8 kf = *(const LAS bf16x8*)(ldb + (16 * kt + i16) * AT_KS + (32 * ks + 8 * g4) * 2); a = mfma16(kf, Qf[ks], a); }
#pragma unroll
                    for (int r = 0; r < 4; ++r) { float v = a[r];
                        if (MODE == 0) { const float dist = fabsf(fb - (float)(16 * kt + r)); v = v + cu.nslope2 * dist; v = dist > 128.0f ? -1e30f : v; }
                        a[r] = v; mx = fmaxf(mx, v); }
                    sc[kt] = a; }
                else sc[kt] = (f32x4){-1e30f, -1e30f, -1e30f, -1e30f}; }
            mx = xmax16(mx); mx = xmax32(mx);
            const float mnew = fmaxf(mrun, mx), alpha = fast_exp2(mrun - mnew); mrun = mnew;
            float ls = 0.f;
#pragma unroll
            for (int kt = 0; kt < 8; ++kt) {
                if ((actm >> kt) & 1u) {
#pragma unroll
                    for (int r = 0; r < 4; ++r) { const float pv = fast_exp2(sc[kt][r] - mnew); sc[kt][r] = pv; ls += pv; } }
                else sc[kt] = (f32x4){0.f, 0.f, 0.f, 0.f}; }
            lrun = lrun * alpha + ls;
#pragma unroll
            for (int d = 0; d < 8; ++d) O[d] = O[d] * alpha;
            const LAS unsigned char* vb = ldb + AT_VOFF + (4 * g4 + (i16 >> 2)) * AT_VS + (4 * (i16 & 3)) * 2;
#pragma unroll
            for (int k2 = 0; k2 < 4; ++k2) {
                if ((actm >> (2 * k2)) & 3u) {
                    u32x4 w; w.x = pk2(sc[2 * k2][0], sc[2 * k2][1]); w.y = pk2(sc[2 * k2][2], sc[2 * k2][3]); w.z = pk2(sc[2 * k2 + 1][0], sc[2 * k2 + 1][1]); w.w = pk2(sc[2 * k2 + 1][2], sc[2 * k2 + 1][3]);
                    const bf16x8 pf = u4_to_bf8(w);
#pragma unroll
                    for (int d = 0; d < 8; ++d) { const s16x4 lo = tr_read(vb + (32 * k2) * AT_VS + 32 * d), hi = tr_read(vb + (32 * k2 + 16) * AT_VS + 32 * d);
                        O[d] = mfma16(cat4(lo, hi), pf, O[d]); } } }
        }
        float lt = lrun; lt = xadd16(lt); lt = xadd32(lt);
        const float il = 1.0f / lt;
        bf16_t* orow = cat + (size_t)(cu.qrow0 + 16 * wave + i16) * DM + cu.ocol + 4 * g4;
#pragma unroll
        for (int d = 0; d < 8; ++d) { u32x2 w; w.x = pk2(O[d][0] * il, O[d][1] * il); w.y = pk2(O[d][2] * il, O[d][3] * il); *(u32x2*)(orow + 16 * d) = w; }
        if (!has_next) break;
        u = un; cu = nu_;
    }
#undef AT_PREFETCH
}
__device__ __forceinline__ void phase_attn(const Params& p, int L, bool windowed, LAS unsigned char* lds, int tid, int lane, int wave) {
    if (windowed) { phase_attn_mode<0>(p, L, lds, tid, lane, wave); __syncthreads(); }
    phase_attn_mode<1>(p, L, lds, tid, lane, wave);
    __syncthreads();
}

#define GLD16(ub, lo) (*(const u32x4*)((const char*)(ub) + (lo)))
#define GLD8(ub, lo) (*(const u32x2*)((const char*)(ub) + (lo)))
__device__ __forceinline__ float log2_gamma(float x) { return -log1pf(expf(-x)) * LOG2E; }
constexpr int RT_KS = 288, RT_VS = 544;
__device__ __forceinline__ void phase_ret_kv(const Params& p, int L, LAS unsigned char* lds, int tid, int lane, int wave) {
    const int li = L >> 1; const char* proj = (const char*)(p.ws + WS_PROJ);
    bf16_t* kvc = (bf16_t*)(p.ws + WS_KVC);
    const int i16 = lane & 15, g4 = lane >> 4;
    constexpr int KIMG = 128 * RT_KS, VOFF = 2 * KIMG;
    const unsigned lk = (unsigned)((tid >> 4) * RET_W * 2 + (tid & 15) * 16), lv = (unsigned)((tid >> 5) * RET_W * 2 + (tid & 31) * 16);
    u32x4 kraw[4], vraw[8];
#define RK_PREFETCH(U) do { const int h_ = (U) % 6, n_ = ((U) / 6) & 63, b_ = (U) / 384; const char* pr_ = proj + ((size_t)b_ * SEQ + n_ * 128) * RET_W * 2; \
        _Pragma("unroll") for (int c = 0; c < 4; ++c) kraw[c] = GLD16(pr_ + (size_t)(32 * c) * RET_W * 2 + 1536 + h_ * 256, lk); \
        _Pragma("unroll") for (int c = 0; c < 8; ++c) vraw[c] = GLD16(pr_ + (size_t)(16 * c) * RET_W * 2 + 3072 + h_ * 512, lv); } while (0)
    int u = xcd_vcu(); if (u >= 768) return;
    RK_PREFETCH(u);
    for (;;) {
        const int h = u % 6, n = (u / 6) & 63, b = u / 384;
        const float lgf = log2_gamma(p.in[I_RDF][li * 6 + h]), lgb = log2_gamma(p.in[I_RDB][li * 6 + h]);
        __syncthreads();
#pragma unroll
        for (int c = 0; c < 4; ++c) { const int row = (tid >> 4) + 32 * c; const u32x4 raw = kraw[c];
#pragma unroll
            for (int dir = 0; dir < 2; ++dir) {
                const float z = fast_exp2(dir ? lgb * (float)row : lgf * (float)(127 - row));
                u32x4 w; w.x = pk2(__uint_as_float(raw.x << 16) * z, __uint_as_float(raw.x & 0xffff0000u) * z); w.y = pk2(__uint_as_float(raw.y << 16) * z, __uint_as_float(raw.y & 0xffff0000u) * z);
                w.z = pk2(__uint_as_float(raw.z << 16) * z, __uint_as_float(raw.z & 0xffff0000u) * z); w.w = pk2(__uint_as_float(raw.w << 16) * z, __uint_as_float(raw.w & 0xffff0000u) * z);
                *(LAS u32x4*)(lds + dir * KIMG + row * RT_KS + (tid & 15) * 16) = w; } }
#pragma unroll
        for (int c = 0; c < 8; ++c) *(LAS u32x4*)(lds + VOFF + ((tid >> 5) + 16 * c) * RT_VS + (tid & 31) * 16) = vraw[c];
        __syncthreads();
        const int un = u + (int)gridDim.x; const bool has_next = un < 768;
        if (has_next) RK_PREFETCH(un);
        const LAS unsigned char* vb = lds + VOFF + (4 * g4 + (i16 >> 2)) * RT_VS + (4 * (i16 & 3)) * 2 + 64 * wave;
#pragma unroll 1
        for (int dir = 0; dir < 2; ++dir) {
            f32x4 acc[8][2];
#pragma unroll
            for (int d = 0; d < 8; ++d) { acc[d][0] = (f32x4){0.f, 0.f, 0.f, 0.f}; acc[d][1] = (f32x4){0.f, 0.f, 0.f, 0.f}; }
            const LAS unsigned char* kb = lds + dir * KIMG + (4 * g4 + (i16 >> 2)) * RT_KS + (4 * (i16 & 3)) * 2;
#pragma unroll
            for (int ks = 0; ks < 4; ++ks) {
                bf16x8 bf[2];
#pragma unroll
                for (int et = 0; et < 2; ++et) bf[et] = cat4(tr_read(vb + (32 * ks) * RT_VS + 32 * et), tr_read(vb + (32 * ks + 16) * RT_VS + 32 * et));
#pragma unroll
                for (int d = 0; d < 8; ++d) { const bf16x8 af = cat4(tr_read(kb + (32 * ks) * RT_KS + 32 * d), tr_read(kb + (32 * ks + 16) * RT_KS + 32 * d));
                    acc[d][0] = mfma16(af, bf[0], acc[d][0]); acc[d][1] = mfma16(af, bf[1], acc[d][1]); }
            }
            bf16_t* o = kvc + ((size_t)((dir * 2 + b) * 6 + h) * 64 + n) * 32768;
#pragma unroll
            for (int et = 0; et < 2; ++et)
#pragma unroll
                for (int d = 0; d < 8; ++d) { u32x2 w; w.x = pk2(acc[d][et][0], acc[d][et][1]); w.y = pk2(acc[d][et][2], acc[d][et][3]);
                    *(u32x2*)(o + (size_t)(32 * wave + 16 * et + i16) * 128 + 16 * d + 4 * g4) = w; }
        }
        if (!has_next) break;
        u = un;
    }
    __syncthreads();
#undef RK_PREFETCH
}
__device__ __forceinline__ void phase_ret_scan(const Params& p, int L, int tid) {
    const int li = L >> 1; const bf16_t* kvc = (const bf16_t*)(p.ws + WS_KVC); bf16_t* st = (bf16_t*)(p.ws + WS_ST);
    for (int task = bidx() * 512 + tid; task < 24 * 4096; task += gridDim.x * 512) {
        const int seq = task >> 12, off = (task & 4095) * 8; const int h = seq % 6, dir = seq / 12;
        const float dec = fast_exp2(log2_gamma(dir ? p.in[I_RDB][li * 6 + h] : p.in[I_RDF][li * 6 + h]) * 128.0f);
        const size_t base = (size_t)seq * 64 * 32768 + off;
        float s[8];
#pragma unroll
        for (int j = 0; j < 8; ++j) s[j] = 0.f;
#pragma unroll 1
        for (int q0 = 0; q0 < 64; q0 += 32) {
            u32x4 kv[32];
#pragma unroll
            for (int i = 0; i < 32; ++i) { const int n = dir ? 63 - (q0 + i) : q0 + i; kv[i] = *(const u32x4*)(kvc + base + (size_t)n * 32768); }
#pragma unroll
            for (int i = 0; i < 32; ++i) { const int n = dir ? 63 - (q0 + i) : q0 + i;
                u32x4 w; w.x = pk2(s[0], s[1]); w.y = pk2(s[2], s[3]); w.z = pk2(s[4], s[5]); w.w = pk2(s[6], s[7]);
                *(u32x4*)(st + base + (size_t)n * 32768) = w;
                s[0] = s[0] * dec + __uint_as_float(kv[i].x << 16); s[1] = s[1] * dec + __uint_as_float(kv[i].x & 0xffff0000u);
                s[2] = s[2] * dec + __uint_as_float(kv[i].y << 16); s[3] = s[3] * dec + __uint_as_float(kv[i].y & 0xffff0000u);
                s[4] = s[4] * dec + __uint_as_float(kv[i].z << 16); s[5] = s[5] * dec + __uint_as_float(kv[i].z & 0xffff0000u);
                s[6] = s[6] * dec + __uint_as_float(kv[i].w << 16); s[7] = s[7] * dec + __uint_as_float(kv[i].w & 0xffff0000u); }
        }
    }
}
__device__ __forceinline__ void phase_ret_out(const Params& p, int L, LAS unsigned char* lds, int tid, int lane, int wave) {
    const int li = L >> 1; const char* proj = (const char*)(p.ws + WS_PROJ); const char* st = (const char*)(p.ws + WS_ST);
    char* cat = (char*)(p.ws + WS_CAT);
    const int i16 = lane & 15, g4 = lane >> 4;
    constexpr int QS = 272, KOFF = 128 * QS, VOFF = 2 * 128 * QS, ROFF = VOFF + 128 * RT_VS;
    LAS float* red = (LAS float*)(lds + ROFF);
    u32x4 sq[4], sk[4];
    const unsigned lo = (unsigned)((tid >> 4) * RET_W * 2 + (tid & 15) * 16);
    const unsigned lv = (unsigned)((tid >> 5) * RET_W * 2 + (tid & 31) * 16);
#define RO_PREFETCH(U) do { const int h_ = (U) % 6, n_ = ((U) / 6) & 63, b_ = (U) / 384; const char* pr_ = proj + ((size_t)b_ * SEQ + n_ * 128) * RET_W * 2; \
        _Pragma("unroll") for (int c = 0; c < 4; ++c) { sq[c] = GLD16(pr_ + (size_t)(32 * c) * RET_W * 2 + h_ * 256, lo); sk[c] = GLD16(pr_ + (size_t)(32 * c) * RET_W * 2 + 1536 + h_ * 256, lo); } } while (0)
    int u = bidx(); if (u >= 768) return;
    RO_PREFETCH(u);
    for (;;) {
        const int h = u % 6, n = (u / 6) & 63, b = u / 384;
        const int un = u + (int)gridDim.x; const bool has_next = un < 768;
        const float lgf = log2_gamma(p.in[I_RDF][li * 6 + h]), lgb = log2_gamma(p.in[I_RDB][li * 6 + h]);
        const size_t row0 = (size_t)b * SEQ + n * 128;
        const char* prow = proj + row0 * RET_W * 2;
        const unsigned lst = (unsigned)(i16 * 256 + g4 * 16);
        u32x4 stf[2][4][2];
#define RO_STATE(dir) do { const char* sp = st + (((size_t)(((dir) * 2 + b) * 6 + h) * 64 + n) * 32768 + (size_t)(32 * wave) * 128) * 2; \
        _Pragma("unroll") for (int ks = 0; ks < 4; ++ks) { stf[dir][ks][0] = GLD16(sp + 64 * ks, lst); stf[dir][ks][1] = GLD16(sp + 16 * 256 + 64 * ks, lst); } } while (0)
        RO_STATE(0);
        __syncthreads();
#pragma unroll
        for (int c = 0; c < 4; ++c) {
            *(LAS u32x4*)(lds + ((tid >> 4) + 32 * c) * QS + (tid & 15) * 16) = sq[c];
            *(LAS u32x4*)(lds + KOFF + ((tid >> 4) + 32 * c) * QS + (tid & 15) * 16) = sk[c]; }
        u32x4 sv[8];
#pragma unroll
        for (int c = 0; c < 8; ++c) sv[c] = GLD16(prow + (size_t)(16 * c) * RET_W * 2 + 3072 + h * 512, lv);
        __syncthreads();
        {
            f32x4 sc[8];
            { bf16x8 qf[4];
#pragma unroll
              for (int ks = 0; ks < 4; ++ks) qf[ks] = *(const LAS bf16x8*)(lds + (16 * wave + i16) * QS + (32 * ks + 8 * g4) * 2);
#pragma unroll
              for (int s8 = 0; s8 < 8; ++s8) { f32x4 a = (f32x4){0.f, 0.f, 0.f, 0.f};
#pragma unroll
                  for (int ks = 0; ks < 4; ++ks) { const bf16x8 kf = *(const LAS bf16x8*)(lds + KOFF + (16 * s8 + i16) * QS + (32 * ks + 8 * g4) * 2); a = mfma16(kf, qf[ks], a); }
                  sc[s8] = a; if (s8 & 1) asm volatile("" ::: "memory"); } }
            { int t = 16 * wave + i16 - 4 * g4; asm volatile("" : "+v"(t));
#pragma unroll
              for (int s8 = 0; s8 < 8; ++s8)
#pragma unroll
                  for (int r = 0; r < 4; ++r) { const int dl = t - (16 * s8 + r);
                      const float dcy = dl >= 0 ? fast_exp2(lgf * (float)dl) : fast_exp2(lgb * (float)(-dl)); sc[s8][r] = sc[s8][r] * dcy; } }
#pragma unroll
            for (int c = 0; c < 8; ++c) *(LAS u32x4*)(lds + VOFF + ((tid >> 5) + 16 * c) * RT_VS + (tid & 31) * 16) = sv[c];
            __syncthreads();
#pragma unroll
            for (int s8 = 0; s8 < 8; ++s8) { u32x2 w; w.x = pk2(sc[s8][0], sc[s8][1]); w.y = pk2(sc[s8][2], sc[s8][3]);
                *(LAS u32x2*)(lds + KOFF + (16 * wave + i16) * QS + (16 * s8 + 4 * g4) * 2) = w; }
            __syncthreads();
        }
        RO_STATE(1);
        f32x4 acc[2][8];
#pragma unroll
        for (int et = 0; et < 2; ++et)
#pragma unroll
            for (int tt = 0; tt < 8; ++tt) acc[et][tt] = (f32x4){0.f, 0.f, 0.f, 0.f};
        { const LAS unsigned char* qb = lds + i16 * QS + (8 * g4) * 2;
#pragma unroll
          for (int dir = 0; dir < 2; ++dir) {
#pragma unroll
            for (int ks = 0; ks < 4; ++ks) {
                const bf16x8 a0 = u4_to_bf8(stf[dir][ks][0]), a1 = u4_to_bf8(stf[dir][ks][1]);
#pragma unroll
                for (int tt = 0; tt < 8; ++tt) { const bf16x8 qf = *(const LAS bf16x8*)(qb + (16 * tt) * QS + 64 * ks);
                    acc[0][tt] = mfma16(a0, qf, acc[0][tt]); acc[1][tt] = mfma16(a1, qf, acc[1][tt]); }
                asm volatile("" ::: "memory");
            }
#pragma unroll
            for (int tt = 0; tt < 8; ++tt) { const float t = (float)(16 * tt + i16);
                const float f = dir == 0 ? fast_exp2(lgf * (t + 1.0f) - lgb * (128.0f - t)) : fast_exp2(lgb * (128.0f - t));
                acc[0][tt] = acc[0][tt] * f; acc[1][tt] = acc[1][tt] * f; }
          } }
        if (has_next) RO_PREFETCH(un);
        const unsigned lg = (unsigned)(i16 * RET_W * 2 + g4 * 8);
        u32x2 grv[8][2];
#pragma unroll
        for (int tt = 0; tt < 8; ++tt) { const char* gbase = prow + (size_t)(16 * tt) * RET_W * 2 + (3072 + h * 256 + 32 * wave) * 2;
            grv[tt][0] = GLD8(gbase, lg); grv[tt][1] = GLD8(gbase + 32, lg); }
        { const LAS unsigned char* vb = lds + VOFF + (4 * g4 + (i16 >> 2)) * RT_VS + (4 * (i16 & 3)) * 2 + 64 * wave;
          const LAS unsigned char* pb = lds + KOFF + i16 * QS + (4 * g4) * 2;
#pragma unroll 1
          for (int ks = 0; ks < 4; ++ks) {
              const bf16x8 v0 = cat4(tr_read(vb + (32 * ks) * RT_VS), tr_read(vb + (32 * ks + 16) * RT_VS));
              const bf16x8 v1 = cat4(tr_read(vb + (32 * ks) * RT_VS + 32), tr_read(vb + (32 * ks + 16) * RT_VS + 32));
#pragma unroll
              for (int tt = 0; tt < 8; ++tt) { const LAS unsigned char* pr = pb + (16 * tt) * QS + 64 * ks;
                  const u32x2 plo = *(const LAS u32x2*)pr, phi = *(const LAS u32x2*)(pr + 32);
                  u32x4 pw; pw.x = plo.x; pw.y = plo.y; pw.z = phi.x; pw.w = phi.y; const bf16x8 pf = u4_to_bf8(pw);
                  acc[0][tt] = mfma16(v0, pf, acc[0][tt]); acc[1][tt] = mfma16(v1, pf, acc[1][tt]); }
          } }
        const float kscale = 0.08838834764831845f;
#pragma unroll
        for (int tt = 0; tt < 8; ++tt) { float ss = 0.f;
#pragma unroll
            for (int et = 0; et < 2; ++et) { acc[et][tt] = acc[et][tt] * kscale; ss += (acc[et][tt][0] * acc[et][tt][0] + acc[et][tt][1] * acc[et][tt][1]) + (acc[et][tt][2] * acc[et][tt][2] + acc[et][tt][3] * acc[et][tt][3]); }
            ss = xadd16(ss); ss = xadd32(ss);
            if (g4 == 0) red[wave * 128 + 16 * tt + i16] = ss; }
        __syncthreads();
        const float* og = p.in[I_ROG] + (size_t)li * 1536 + h * 256 + 32 * wave;
        const f32x4 gn0 = *(const f32x4*)(og + 4 * g4), gn1 = *(const f32x4*)(og + 16 + 4 * g4);
        const unsigned lc = (unsigned)(i16 * DM * 2 + g4 * 8);
#pragma unroll
        for (int tt = 0; tt < 8; ++tt) { const int t = 16 * tt + i16; float tot = 0.f;
#pragma unroll
            for (int w = 0; w < 8; ++w) tot += red[w * 128 + t];
            const float rs = 1.0f / sqrtf(tot * (1.0f / 256.0f) + EPS);
            char* cbase = cat + (row0 + 16 * tt) * DM * 2 + (h * 256 + 32 * wave) * 2;
#pragma unroll
            for (int et = 0; et < 2; ++et) {
                const u32x2 gr = grv[tt][et];
                const f32x4 gn = et ? gn1 : gn0;
                const float y0 = acc[et][tt][0] * rs * gn[0] * silu_f(__uint_as_float(gr.x << 16)), y1 = acc[et][tt][1] * rs * gn[1] * silu_f(__uint_as_float(gr.x & 0xffff0000u));
                const float y2 = acc[et][tt][2] * rs * gn[2] * silu_f(__uint_as_float(gr.y << 16)), y3 = acc[et][tt][3] * rs * gn[3] * silu_f(__uint_as_float(gr.y & 0xffff0000u));
                u32x2 w; w.x = pk2(y0, y1); w.y = pk2(y2, y3);
                *(u32x2*)(cbase + 32 * et + lc) = w; } }
        if (!has_next) break;
        u = un;
    }
#undef RO_PREFETCH
#undef RO_STATE
    __syncthreads();
}

constexpr int NPH = 10;
constexpr int N_STEPS = 2 + DEPTH * NPH + 1;
__global__ void __launch_bounds__(512, 2) mega(Params p0) {
    extern __shared__ __attribute__((aligned(16))) unsigned char lds_raw[];
    LAS unsigned char* lds = (LAS unsigned char*)lds_raw;
    const int tid0 = threadIdx.x;
    const int G = gridDim.x; const int ngw = G * 8;
    volatile LAS unsigned* misc = (volatile LAS unsigned*)(lds + LDS_MISC);
    if (tid0 < 4) misc[tid0] = 0u;
    __syncthreads();
    unsigned* ctl = (unsigned*)(p0.ws + WS_CTL);
    XcdBarrier bar = xcd_barrier_post(ctl + 4096 + (size_t)p0.li * XCD_BAR_WORDS, misc);
    const int lo = p0.lo, hi = p0.hi; bool did = false; int L_ = 0;
    const bool defer_moe = (G >= 64) && (DEFER_MOE != 0);
    const bool merge_rt = (G == 256) && (lo == 0) && (hi == N_STEPS) && (MERGE_RT != 0);
    const bool split_cv = defer_moe && (G == 256) && (SPLIT_CV != 0);
#define STEP(k) if (lo <= (k) && (k) < hi && ((did ? (xcd_barrier(bar), 0) : 0), did = true, true))
#define FRESH() int tid = tid0; asm volatile("" : "+v"(tid)); const int lane = tid & 63, wave = __builtin_amdgcn_readfirstlane(tid >> 6); const int gw = bidx() * 8 + wave; const __attribute__((address_space(4))) Params* kp_ = (const __attribute__((address_space(4))) Params*)__builtin_amdgcn_kernarg_segment_ptr(); asm volatile("" : "+s"(kp_)); Params p; _Pragma("unroll") for (int i_ = 0; i_ < 21; ++i_) p.in[i_] = kp_->in[i_]; p.out = kp_->out; p.ws = kp_->ws; p.lo = 0; p.hi = 0; p.li = 0; p.pad = 0; unsigned char* ws = p.ws; (void)lane; (void)gw; (void)ws; int L = L_; asm volatile("" : "+s"(L)); const bool ret = (L & 1) != 0; const int li = L >> 1; (void)ret; (void)li

    STEP(0) { FRESH(); for (int rep_ = 0; rep_ < (DUP_ON(0) ? 2 : 1); ++rep_) { if (rep_) xcd_barrier(bar); if (PH_ON(0)) phase_convert(p, !defer_moe, split_cv ? 1 : 0, lds, gw, ngw, wave, lane); } if (PH_ON(2)) phase_norm1(p, 0, false, true, gw, ngw, lane); }
    STEP(1) if (PH_ON(1)) { FRESH();
        pg8::Gemm g{(const bf16_t*)(ws + WS_MEMN), (const bf16_t*)(ws + WS_WMKV), 2048, 4096, DM, nullptr};
        pg8::EpiProj E{(bf16_t*)(ws + WS_KVM), 4096, (float*)(ws + WS_PARTM), 32, 0x0F0F0F0Full, nullptr};
        if (split_cv) {
            pg8::DiagOrder S{bidx()};
            pg8::gemm_phase<pg8::EpiProj, pg8::DiagOrder, false>(lds, g, S, E);
            if (bidx() >= 32) phase_convert(p, false, 2, lds, (bidx() - 32) * 8 + wave, 224 * 8, wave, lane);
        } else {
            pg8::StaticOrder S; S.init(2048, 4096, G, bidx());
            for (int rep_ = 0; rep_ < (DUP_ON(1) ? 2 : 1); ++rep_) { if (rep_) xcd_barrier(bar); pg8::gemm_phase<pg8::EpiProj, pg8::StaticOrder, false>(lds, g, S, E); }
        }
    }
#pragma unroll 1
    for (int Lo = 0; Lo < NLAYERS; ++Lo) {
        const int base = 2 + Lo * NPH; const bool ret = (Lo & 1) != 0; L_ = Lo;
        if (Lo > 0) { STEP(base + 0) { FRESH(); if (PH_ON(2)) phase_norm1(p, L, true, true, gw, ngw, lane); if (DUP_ON(2)) { xcd_barrier(bar); phase_norm1(p, L, true, true, gw, ngw, lane); } } }
        STEP(base + 1) if (PH_ON(3)) { FRESH();
            const int N = ret ? RET_W : ATT_W;
            pg8::Gemm g{(const bf16_t*)(ws + WS_H), ret ? (const bf16_t*)(ws + WS_WINR) + (size_t)li * RET_W * DM : (const bf16_t*)(ws + WS_WINA) + (size_t)li * ATT_W * DM, TT, N, DM, nullptr};
            pg8::StaticOrder S; S.init(TT, N, G, bidx());
            pg8::EpiProj E{(bf16_t*)(ws + WS_PROJ), N, (float*)(ws + WS_PART), N >> 7, ret ? 0xF000000000ull : 0xF0FFFFull, (const float*)(ws + WS_RS1)};
            for (int rep_ = 0; rep_ < (DUP_ON(3) ? 2 : 1); ++rep_) { if (rep_) xcd_barrier(bar); pg8::gemm_phase<pg8::EpiProj, pg8::StaticOrder, false>(lds, g, S, E); }
        }
        if (!ret) {
            STEP(base + 2) { FRESH(); if (PH_ON(4)) phase_attn(p, L, true, lds, tid, lane, wave); if (DUP_ON(4)) { xcd_barrier(bar); phase_attn(p, L, true, lds, tid, lane, wave); } }
        } else {
            STEP(base + 2) { FRESH(); if (PH_ON(5)) phase_ret_kv(p, L, lds, tid, lane, wave); if (DUP_ON(5)) { xcd_barrier(bar); phase_ret_kv(p, L, lds, tid, lane, wave); } if (PH_ON(14)) phase_attn(p, L, false, lds, tid, lane, wave); if (DUP_ON(14)) { xcd_barrier(bar); phase_attn(p, L, false, lds, tid, lane, wave); } }
            STEP(base + 3) { FRESH(); for (int rep_ = 0; rep_ < (DUP_ON(6) ? 2 : 1); ++rep_) { if (rep_) xcd_barrier(bar); if (PH_ON(6)) phase_ret_scan(p, L, tid); } }
            STEP(base + 4) { FRESH(); for (int rep_ = 0; rep_ < (DUP_ON(7) ? 2 : 1); ++rep_) { if (rep_) xcd_barrier(bar); if (PH_ON(7)) phase_ret_out(p, L, lds, tid, lane, wave); } }
        }
        STEP(base + 5) if (PH_ON(8)) { FRESH();
            pg8::Gemm g{(const bf16_t*)(ws + WS_CAT), (const bf16_t*)(ws + WS_WOUT) + (size_t)L * DM * DM, TT, DM, DM, nullptr};
            pg8::StaticOrder S; S.init(TT, DM, G, bidx());
            pg8::EpiDelta E{(bf16_t*)(ws + WS_XR), DM, (const bf16_t*)(ws + WS_H)};
            for (int rep_ = 0; rep_ < (DUP_ON(8) ? 2 : 1); ++rep_) { if (rep_) xcd_barrier(bar); pg8::gemm_phase<pg8::EpiDelta, pg8::StaticOrder, false>(lds, g, S, E); }
        }
        STEP(base + 6) { FRESH(); for (int rep_ = 0; rep_ < (DUP_ON(9) ? 2 : 1); ++rep_) { if (rep_) xcd_barrier(bar); if (PH_ON(9)) phase_router(p, L, lds, gw, ngw, tid, lane); }
            if (merge_rt) router_publish(ctl + 8192 + (L * 2 + (bidx() >> 7)) * 64); }
        if (merge_rt ? (lo <= base + 6 && base + 6 < hi) : (lo <= base + 7 && base + 7 < hi && ((did ? (xcd_barrier(bar), 0) : 0), did = true, true))) { FRESH();
            if (merge_rt && bidx() < 32) router_wait(ctl + 8192 + (L * 2 + (bidx() >> 4)) * 64, 128u, ctl + 4096 + XB_TMO);
            for (int rep_ = 0; rep_ < (DUP_ON(10) ? 2 : 1); ++rep_) { if (rep_) xcd_barrier(bar); if (PH_ON(10)) phase_topk(p, lds, tid, lane, wave); }
            if (defer_moe) {
                const int nA = (G == 256) ? 2560 : 0, nB = 24576 - nA;
                if (bidx() >= 32) convert_moe_layer(p, L, 0, nB, (bidx() - 32) * 8 + wave, (G - 32) * 8, lds, wave, lane);
                else if (nA) convert_moe_layer(p, L, nB, 24576, bidx() * 8 + wave, 256, lds, wave, lane);
            } }
        STEP(base + 8) if (PH_ON(11)) { FRESH();
            pg8::Gemm g{(const bf16_t*)(ws + WS_XR), (const bf16_t*)(ws + WS_WGU) + (size_t)L * NEXP * 2048 * DM, NSLOT, 2048, DM, (const int*)(ws + WS_ROWIDX)};
            pg8::MoeOrder S{G, bidx()};
            pg8::EpiSwiglu E{(bf16_t*)(ws + WS_HID), (const float*)(ws + WS_RSLOT)};
            for (int rep_ = 0; rep_ < (DUP_ON(11) ? 2 : 1); ++rep_) { if (rep_) xcd_barrier(bar); pg8::gemm_phase<pg8::EpiSwiglu, pg8::MoeOrder, true, MOE_B_AUX>(lds, g, S, E); }
        }
        STEP(base + 9) if (PH_ON(12)) { FRESH();
            pg8::Gemm g{(const bf16_t*)(ws + WS_HID), (const bf16_t*)(ws + WS_WDN) + (size_t)L * NEXP * DM * FF, NSLOT, DM, FF, nullptr};
            pg8::MoeOrder S{G, bidx()};
            pg8::EpiDown E{(bf16_t*)(ws + WS_Y), (const float*)(ws + WS_GATEV)};
            for (int rep_ = 0; rep_ < (DUP_ON(12) ? 2 : 1); ++rep_) { if (rep_) xcd_barrier(bar); pg8::gemm_phase<pg8::EpiDown, pg8::MoeOrder, false, MOE_B_AUX>(lds, g, S, E); }
        }
    }
    if (DUP_ON(20) && hi > 5) { for (int i_ = 0; i_ < 40; ++i_) xcd_barrier(bar); }
    L_ = 0;
    STEP(2 + DEPTH * NPH) { FRESH(); if (PH_ON(13)) phase_norm1(p, 0, true, false, gw, ngw, lane); }
#undef STEP
}

extern "C" void kernel_launch(void* const* d_in, const int* in_sizes, int n_in, void* d_out, int out_size, void* d_ws, size_t ws_size, hipStream_t stream) {
    static int grid = 0;
    if (grid == 0) {
        if (n_in != 21 || out_size != TT * DM || ws_size < WS_END) { fprintf(stderr, "kernel_launch: unexpected shapes (n_in %d out %d ws %zu)\n", n_in, out_size, ws_size); grid = -1; return; }
        int dev = 0, cus = 0, per_cu = 0;
        if (hipGetDevice(&dev) != hipSuccess || hipDeviceGetAttribute(&cus, hipDeviceAttributeMultiprocessorCount, dev) != hipSuccess) { grid = -1; return; }
        if (hipFuncSetAttribute((const void*)mega, hipFuncAttributeMaxDynamicSharedMemorySize, LDS_BYTES) != hipSuccess) { fprintf(stderr, "kernel_launch: hipFuncSetAttribute failed\n"); grid = -1; return; }
        if (hipOccupancyMaxActiveBlocksPerMultiprocessor(&per_cu, (const void*)mega, 512, LDS_BYTES) != hipSuccess || per_cu < 1) fprintf(stderr, "kernel_launch: occupancy query says %d\n", per_cu);
        (void)hipGetLastError();
        grid = cus;
    }
    if (grid < 0) return;
    (void)hipMemsetAsync((char*)d_ws + WS_CTL, 0, MK_FUSED ? (size_t)65536 : CTL_BYTES, stream);
    Params a{};
    for (int i = 0; i < 21; ++i) a.in[i] = (const float*)d_in[i];
    a.out = (float*)d_out; a.ws = (unsigned char*)d_ws; a.pad = 0;
#if MK_FUSED
    a.lo = 0; a.hi = N_STEPS; a.li = 0;
    hipLaunchKernelGGL(mega, dim3(grid), dim3(512), LDS_BYTES, stream, a);
#else
    int li = 0;
    for (int s = 0; s < N_STEPS; ++s) {
        if (s >= 2 && s < 2 + DEPTH * NPH) { const int L = (s - 2) / NPH, ph = (s - 2) % NPH; if ((L & 1) == 0 && (ph == 3 || ph == 4)) continue; }
        a.lo = s; a.hi = s + 1; a.li = li++;
        hipLaunchKernelGGL(mega, dim3(grid), dim3(512), LDS_BYTES, stream, a);
    }
#endif
}
```

```cpp
#include <hip/hip_runtime.h>
#include <cstdio>
#include <cstdint>

#define LAS __attribute__((address_space(3)))
typedef unsigned short bf16_t;
typedef short bf16x8 __attribute__((ext_vector_type(8)));
typedef short s16x4 __attribute__((ext_vector_type(4)));
typedef float f32x4 __attribute__((ext_vector_type(4)));
typedef float f32x2 __attribute__((ext_vector_type(2)));
typedef unsigned u32x4 __attribute__((ext_vector_type(4)));
typedef unsigned u32x2 __attribute__((ext_vector_type(2)));

#ifndef PHMASK
#define PHMASK 0xFFFFFFFFu
#endif
#ifndef PHMASK2
#define PHMASK2 0xFFFFFFFFu
#endif
#define PH_ON(k) ((((PHMASK) >> (k)) & 1u) && (L_ < 2 || (((PHMASK2) >> (k)) & 1u)))
#ifndef DUPMASK
#define DUPMASK 0u
#endif
#define DUP_ON(k) (((DUPMASK) >> (k)) & 1u)
#ifndef MERGE_RT
#define MERGE_RT 1
#endif
#ifndef MOE_B_AUX
#define MOE_B_AUX 0
#endif
#ifndef SPLIT_CV
#define SPLIT_CV 1
#endif
#ifndef DEFER_MOE
#define DEFER_MOE 1
#endif
#ifndef NLAYERS
#define NLAYERS 4
#endif
#ifndef MK_FUSED
#define MK_FUSED 1
#endif

constexpr int NB = 2, SEQ = 8192, DM = 2048, TT = NB * SEQ, DEPTH = 4;
constexpr int NEXP = 16, FF = 1024, CAP = 1024, NSLOT = NB * NEXP * CAP;
constexpr int ATT_W = 3072, RET_W = 5120, MEML = 256;
constexpr float EPS = 1e-6f;
constexpr float LOG2E = 1.4426950408889634f;
constexpr float QSCALE2 = 0.08838834764831845f * 1.4426950408889634f;

constexpr size_t MiB = (size_t)1 << 20;
constexpr size_t WS_CTL = 0, CTL_BYTES = 1 * MiB;
constexpr size_t WS_WINA = 1 * MiB;
constexpr size_t WS_WINR = 25 * MiB;
constexpr size_t WS_WMKV = 65 * MiB;
constexpr size_t WS_WOUT = 81 * MiB;
constexpr size_t WS_WGU = 113 * MiB;
constexpr size_t WS_WDN = 625 * MiB;
constexpr size_t WS_MEMN = 881 * MiB;
constexpr size_t WS_KVM = 889 * MiB;
constexpr size_t WS_PARTM = 905 * MiB;
constexpr size_t WS_H = 906 * MiB;
constexpr size_t WS_PROJ = 970 * MiB;
constexpr size_t WS_PART = 1130 * MiB;
constexpr size_t WS_CAT = 1140 * MiB;
constexpr size_t WS_KVC = 1204 * MiB;
constexpr size_t WS_ST = 1300 * MiB;
constexpr size_t WS_HID = 1396 * MiB;
constexpr size_t WS_Y = 1460 * MiB;
constexpr size_t WS_AFF = 1588 * MiB;
constexpr size_t WS_ROWIDX = 1589 * MiB;
constexpr size_t WS_GATEV = 1589 * MiB + 256 * 1024;
constexpr size_t WS_RSLOT = 1589 * MiB + 512 * 1024;
constexpr size_t WS_RS1 = 1589 * MiB + 640 * 1024;
constexpr size_t WS_RS2 = 1589 * MiB + 704 * 1024;
constexpr size_t WS_INV = 1590 * MiB;
constexpr size_t WS_XR = 1591 * MiB;
constexpr size_t WS_END = 1655 * MiB;

constexpr int LDS_BYTES = 160 * 1024;
constexpr int LDS_MISC = LDS_BYTES - 256;

__device__ __forceinline__ float bf2f(unsigned short b) { return __uint_as_float(((unsigned)b) << 16); }
typedef __bf16 bf16x2_t __attribute__((ext_vector_type(2)));
__device__ __forceinline__ unsigned pk2(float lo, float hi) { const f32x2 v = {lo, hi}; const bf16x2_t b = __builtin_convertvector(v, bf16x2_t); return __builtin_bit_cast(unsigned, b); }
__device__ __forceinline__ float shx_f(float v, int o, int lane) { return __int_as_float(__builtin_amdgcn_ds_bpermute((lane ^ o) << 2, __float_as_int(v))); }
__device__ __forceinline__ unsigned shup_u(unsigned v, int o, int lane) { return (unsigned)__builtin_amdgcn_ds_bpermute((lane - o) << 2, (int)v); }
#define SHX(v, o) shx_f((v), (o), lane)
__device__ __forceinline__ float xadd16(float x) { const u32x2 r = __builtin_amdgcn_permlane16_swap(__float_as_uint(x), __float_as_uint(x), false, false); return __uint_as_float(r[0]) + __uint_as_float(r[1]); }
__device__ __forceinline__ float xadd32(float x) { const u32x2 r = __builtin_amdgcn_permlane32_swap(__float_as_uint(x), __float_as_uint(x), false, false); return __uint_as_float(r[0]) + __uint_as_float(r[1]); }
__device__ __forceinline__ float xmax16(float x) { const u32x2 r = __builtin_amdgcn_permlane16_swap(__float_as_uint(x), __float_as_uint(x), false, false); return fmaxf(__uint_as_float(r[0]), __uint_as_float(r[1])); }
__device__ __forceinline__ float xmax32(float x) { const u32x2 r = __builtin_amdgcn_permlane32_swap(__float_as_uint(x), __float_as_uint(x), false, false); return fmaxf(__uint_as_float(r[0]), __uint_as_float(r[1])); }
__device__ __forceinline__ float wave_sum(float v, int lane) {
#pragma unroll
    for (int o = 1; o < 64; o <<= 1) v += SHX(v, o);
    return v;
}
__device__ __forceinline__ int bidx() { int b = (int)blockIdx.x; asm volatile("" : "+s"(b)); return b; }
__device__ __forceinline__ float fast_exp2(float x) { return __builtin_amdgcn_exp2f(x); }
__device__ __forceinline__ float silu_f(float x) { return x * __builtin_amdgcn_rcpf(1.0f + __builtin_amdgcn_exp2f(-x * LOG2E)); }
__device__ __forceinline__ s16x4 tr_read(const LAS unsigned char* p) {
    typedef short v4i16_t __attribute__((ext_vector_type(4)));
    return __builtin_bit_cast(s16x4, __builtin_amdgcn_ds_read_tr16_b64_v4i16((LAS v4i16_t*)p));
}
__device__ __forceinline__ bf16x8 cat4(s16x4 lo, s16x4 hi) { bf16x8 r; r[0] = lo[0]; r[1] = lo[1]; r[2] = lo[2]; r[3] = lo[3]; r[4] = hi[0]; r[5] = hi[1]; r[6] = hi[2]; r[7] = hi[3]; return r; }
__device__ __forceinline__ bf16x8 u4_to_bf8(u32x4 w) { return __builtin_bit_cast(bf16x8, w); }
__device__ __forceinline__ f32x4 mfma16(bf16x8 a, bf16x8 b, f32x4 c) { return __builtin_amdgcn_mfma_f32_16x16x32_bf16(a, b, c, 0, 0, 0); }

namespace pg8 {
constexpr int BM = 256, BK = 64, HALF = 128, HTB = HALF * BK * 2, STAGE_BYTES = 8 * HTB, NXCD = 8, WGM = 8;
__host__ __device__ __forceinline__ int lds_byte(int r, int c) { const int st = (r >> 4) * 2 + (c >> 5), rr = r & 15, cc = c & 31, ob = rr * 64 + cc * 2; return st * 1024 + (ob ^ (((ob >> 9) & 1) << 5)); }
__host__ __device__ __forceinline__ void stage_rc(int b, int& R, int& C) { const int st = b / 1024, sb = b % 1024, swz = sb ^ (((sb >> 9) & 1) << 5); R = (st >> 1) * 16 + swz / 64; C = (st & 1) * 32 + (swz % 64) / 2; }
__host__ __device__ __forceinline__ int perm32(int rho) { const int n = rho >> 4, i = rho & 15; return 8 * (i >> 2) + 4 * n + (i & 3); }

struct Unit { int pm, pn; };
struct Gemm { const bf16_t* A; const bf16_t* Bt; int M, N, K; const int* rowidx; };

struct StaticOrder {
    int nM, nN, nwg, G, c;
    __device__ void init(int M, int N, int G_, int c_) { nM = M / BM; nN = N / BM; nwg = nM * nN; G = G_; c = c_; }
    __device__ bool next(int i, Unit& u) const {
        const long L = (long)i * G + c; if (L >= nwg) return false;
        int wgid = (int)L; { const int q = nwg / NXCD, r = nwg % NXCD, xcd = wgid % NXCD, off = wgid / NXCD; wgid = (xcd < r ? xcd * (q + 1) : r * (q + 1) + (xcd - r) * q) + off; }
        const int nig = WGM * nN, gid = wgid / nig, fm = gid * WGM, gsz = (nM - fm) < WGM ? (nM - fm) : WGM;
        u.pm = fm + ((wgid % nig) % gsz); u.pn = (wgid % nig) / gsz; return true;
    }
};
struct DiagOrder {
    int c;
    __device__ bool next(int i, Unit& u) const { if (i != 0 || c >= 32) return false; const int l = c >> 3, j = c & 7; u.pm = 2 * l + (j >> 2); u.pn = 4 * l + (j & 3); return true; }
};
struct MoeOrder {
    int G, c;
    __device__ bool next(int i, Unit& u) const {
        const long v = (long)i * G + c; if (v >= 1024) return false;
        int uu = (int)v;
        if (G == 256) { const int x = c & 7, j = c >> 3; uu = (i * 8 + x) * 32 + j; }
        const int grp = uu >> 5, j = uu & 31, e = grp >> 1, b = grp & 1;
        u.pm = (b * NEXP + e) * 4 + (j >> 3); u.pn = e * 8 + (j & 7); return true;
    }
};

struct EpiProj {
    static constexpr bool PERM = true;
    bf16_t* O; int ldc; float* part; int nh; unsigned long long need; const float* rowscale;
    static constexpr bool HAS_PRE = true;
    __device__ __forceinline__ void pre(const Unit& u, int wr, int fr, f32x4 (&pv)[1]) const {
        const int row0 = u.pm * BM + wr * 64 + fr;
#pragma unroll
        for (int q = 0; q < 4; ++q) pv[0][q] = rowscale ? rowscale[row0 + q * 16] : 1.0f; }
    __device__ __forceinline__ void operator()(const f32x4 (&acc)[2][2][4][2], const Unit& u, int wr, int wc, int fr, int fq, const f32x4 (&pv)[1]) const {
        const int row0 = u.pm * BM + wr * 64 + fr, col0 = u.pn * BM + wc * 32 + 8 * fq;
        const bool nd0 = (need >> (u.pn * 2)) & 1ull, nd1 = (need >> (u.pn * 2 + 1)) & 1ull;
        f32x4 pw; pw[0] = rowscale ? rowscale[row0 + HALF] : 1.0f; pw[1] = rowscale ? rowscale[row0 + HALF + 16] : 1.0f; pw[2] = rowscale ? rowscale[row0 + HALF + 32] : 1.0f; pw[3] = rowscale ? rowscale[row0 + HALF + 48] : 1.0f;
#pragma unroll
        for (int ai = 0; ai < 2; ++ai)
#pragma unroll
            for (int m = 0; m < 4; ++m) { const int row = row0 + ai * HALF + m * 16; bf16_t* rowp = O + (size_t)row * ldc + col0; const float rsc = ai ? pw[m] : pv[0][m];
#pragma unroll
                for (int bj = 0; bj < 2; ++bj) { const f32x4 v0 = acc[ai][bj][m][0] * rsc, v1 = acc[ai][bj][m][1] * rsc;
                    u32x4 w; w.x = pk2(v0[0], v0[1]); w.y = pk2(v0[2], v0[3]); w.z = pk2(v1[0], v1[1]); w.w = pk2(v1[2], v1[3]);
                    *(u32x4*)(rowp + bj * HALF) = w;
                    if (bj ? nd1 : nd0) {
                        float ss = (v0[0] * v0[0] + v0[1] * v0[1]) + (v0[2] * v0[2] + v0[3] * v0[3]) + (v1[0] * v1[0] + v1[1] * v1[1]) + (v1[2] * v1[2] + v1[3] * v1[3]);
                        { const int lane = fq * 16 + fr; ss = xadd16(ss); ss = xadd32(ss); }
                        if (fq == 0) part[((size_t)row * nh + (u.pn * 2 + bj)) * 4 + wc] = ss; } } }
    }
};
struct EpiResid {
    static constexpr bool PERM = false;
    float* X; int ldc;
    __device__ __forceinline__ void operator()(const f32x4 (&acc)[2][2][4][2], const Unit& u, int wr, int wc, int fr, int fq) const {
        const int row0 = u.pm * BM + wr * 64 + fr, col0 = u.pn * BM + wc * 32 + 4 * fq;
#pragma unroll
        for (int ai = 0; ai < 2; ++ai)
#pragma unroll
            for (int m = 0; m < 4; ++m) { float* rowp = X + (size_t)(row0 + ai * HALF + m * 16) * ldc + col0;
#pragma unroll
                for (int bj = 0; bj < 2; ++bj)
#pragma unroll
                    for (int n = 0; n < 2; ++n) { f32x4* q = (f32x4*)(rowp + bj * HALF + n * 16); *q = *q + acc[ai][bj][m][n]; }
                if (m == 3) asm volatile("" ::: "memory"); }
    }
};
struct EpiDelta {
    static constexpr bool PERM = true;
    bf16_t* O; int ldc; const bf16_t* X;
    static constexpr bool HAS_PRE = false;
    __device__ __forceinline__ void pre(const Unit&, int, int, f32x4 (&)[1]) const {}
    __device__ __forceinline__ void operator()(const f32x4 (&acc)[2][2][4][2], const Unit& u, int wr, int wc, int fr, int fq, const f32x4 (&)[1]) const {
        const int row0 = u.pm * BM + wr * 64 + fr, col0 = u.pn * BM + wc * 32 + 8 * fq;
        u32x4 xv[2][4][2];
#pragma unroll
        for (int ai = 0; ai < 2; ++ai)
#pragma unroll
            for (int m = 0; m < 4; ++m)
#pragma unroll
                for (int bj = 0; bj < 2; ++bj) xv[ai][m][bj] = *(const u32x4*)(X + (size_t)(row0 + ai * HALF + m * 16) * ldc + col0 + bj * HALF);
#pragma unroll
        for (int ai = 0; ai < 2; ++ai)
#pragma unroll
            for (int m = 0; m < 4; ++m) { bf16_t* rowp = O + (size_t)(row0 + ai * HALF + m * 16) * ldc + col0;
#pragma unroll
                for (int bj = 0; bj < 2; ++bj) { const f32x4 v0 = acc[ai][bj][m][0], v1 = acc[ai][bj][m][1]; const u32x4 x = xv[ai][m][bj];
                    u32x4 w; w.x = pk2(v0[0] + __uint_as_float(x.x << 16), v0[1] + __uint_as_float(x.x & 0xffff0000u)); w.y = pk2(v0[2] + __uint_as_float(x.y << 16), v0[3] + __uint_as_float(x.y & 0xffff0000u));
                    w.z = pk2(v1[0] + __uint_as_float(x.z << 16), v1[1] + __uint_as_float(x.z & 0xffff0000u)); w.w = pk2(v1[2] + __uint_as_float(x.w << 16), v1[3] + __uint_as_float(x.w & 0xffff0000u));
                    *(u32x4*)(rowp + bj * HALF) = w; } }
    }
};
struct EpiSwiglu {
    static constexpr bool PERM = true;
    bf16_t* O; const float* rss;
    static constexpr bool HAS_PRE = true;
    __device__ __forceinline__ void pre(const Unit& u, int wr, int fr, f32x4 (&pv)[1]) const {
        const int row0 = u.pm * BM + wr * 64 + fr;
#pragma unroll
        for (int q = 0; q < 4; ++q) pv[0][q] = rss[row0 + q * 16]; }
    __device__ __forceinline__ void operator()(const f32x4 (&acc)[2][2][4][2], const Unit& u, int wr, int wc, int fr, int fq, const f32x4 (&pv)[1]) const {
        const int row0 = u.pm * BM + wr * 64 + fr, col0 = (u.pn & 7) * 128 + wc * 32 + 8 * fq;
        f32x4 pw; pw[0] = rss[row0 + HALF]; pw[1] = rss[row0 + HALF + 16]; pw[2] = rss[row0 + HALF + 32]; pw[3] = rss[row0 + HALF + 48];
#pragma unroll
        for (int ai = 0; ai < 2; ++ai)
#pragma unroll
            for (int m = 0; m < 4; ++m) { const float rsc = ai ? pw[m] : pv[0][m];
                const f32x4 g0 = acc[ai][0][m][0] * rsc, g1 = acc[ai][0][m][1] * rsc, u0 = acc[ai][1][m][0] * rsc, u1 = acc[ai][1][m][1] * rsc;
                u32x4 w; w.x = pk2(silu_f(g0[0]) * u0[0], silu_f(g0[1]) * u0[1]); w.y = pk2(silu_f(g0[2]) * u0[2], silu_f(g0[3]) * u0[3]);
                w.z = pk2(silu_f(g1[0]) * u1[0], silu_f(g1[1]) * u1[1]); w.w = pk2(silu_f(g1[2]) * u1[2], silu_f(g1[3]) * u1[3]);
                *(u32x4*)(O + (size_t)(row0 + ai * HALF + m * 16) * FF + col0) = w; }
    }
};
struct EpiDown {
    static constexpr bool PERM = true;
    bf16_t* O; const float* gate;
    static constexpr bool HAS_PRE = true;
    __device__ __forceinline__ void pre(const Unit& u, int wr, int fr, f32x4 (&pv)[1]) const {
        const int row0 = u.pm * BM + wr * 64 + fr;
#pragma unroll
        for (int q = 0; q < 4; ++q) pv[0][q] = gate[row0 + q * 16]; }
    __device__ __forceinline__ void operator()(const f32x4 (&acc)[2][2][4][2], const Unit& u, int wr, int wc, int fr, int fq, const f32x4 (&pv)[1]) const {
        const int row0 = u.pm * BM + wr * 64 + fr, col0 = (u.pn & 7) * BM + wc * 32 + 8 * fq;
        f32x4 pw; pw[0] = gate[row0 + HALF]; pw[1] = gate[row0 + HALF + 16]; pw[2] = gate[row0 + HALF + 32]; pw[3] = gate[row0 + HALF + 48];
#pragma unroll
        for (int ai = 0; ai < 2; ++ai)
#pragma unroll
            for (int m = 0; m < 4; ++m) { const int row = row0 + ai * HALF + m * 16; const float gt = ai ? pw[m] : pv[0][m]; bf16_t* rowp = O + (size_t)row * DM + col0;
#pragma unroll
                for (int bj = 0; bj < 2; ++bj) { const f32x4 v0 = acc[ai][bj][m][0] * gt, v1 = acc[ai][bj][m][1] * gt;
                    u32x4 w; w.x = pk2(v0[0], v0[1]); w.y = pk2(v0[2], v0[3]); w.z = pk2(v1[0], v1[1]); w.w = pk2(v1[2], v1[3]);
                    *(u32x4*)(rowp + bj * HALF) = w; } }
    }
};

template <class Epi, class Sched, bool GATHER, int B_AUX = 0>
__device__ __forceinline__ void gemm_phase(LAS unsigned char* lds, const Gemm g, const Sched& S, const Epi& E) {
    int tid = threadIdx.x; asm volatile("" : "+v"(tid));
    const int wid = __builtin_amdgcn_readfirstlane(tid >> 6), lane = tid & 63, wr = wid >> 2, wc = wid & 3, fr = lane & 15, fq = lane >> 4;
    const int K = g.K, nt = K / BK;
    unsigned voffA[2], voffB[2];
#pragma unroll
    for (int i = 0; i < 2; ++i) { int R, C; stage_rc(tid * 16 + i * 8192, R, C); const int Rb = Epi::PERM ? ((R & ~31) + perm32(R & 31)) : R;
        voffA[i] = (unsigned)(R * K + C) * 2u; voffB[i] = (unsigned)(Rb * K + C) * 2u; }
    const size_t kstep = (size_t)(BK * 2);
    const size_t hstep = (size_t)HALF * K * 2;
    const size_t tstep = 2 * hstep;
    const unsigned ldsw = (unsigned)wid * 1024u;
    const int aoff = lds_byte(wr * 64 + fr, fq * 8), boff = lds_byte(wc * 32 + fr, fq * 8);
    unsigned gA[2][2];
#define PG8_SA(b, h) (((b) * 2 + (h)) * HTB)
#define PG8_SB(b, h) ((4 + (b) * 2 + (h)) * HTB)
#define PG8_STAGE(bufoff, gbase, voff) do { _Pragma("unroll") for (int _i = 0; _i < 2; ++_i) \
        __builtin_amdgcn_global_load_lds((const unsigned*)((const char*)(gbase) + (voff)[_i]), (LAS unsigned*)(lds + (bufoff) + ldsw + _i * 8192), 16, 0, 0); } while (0)
#define PG8_STAGEB(bufoff, gbase, voff) do { _Pragma("unroll") for (int _i = 0; _i < 2; ++_i) \
        __builtin_amdgcn_global_load_lds((const unsigned*)((const char*)(gbase) + (voff)[_i]), (LAS unsigned*)(lds + (bufoff) + ldsw + _i * 8192), 16, 0, B_AUX); } while (0)
#define PG8_ASTAGE(b, h, kp, NX) do { if constexpr (GATHER) { PG8_STAGE(PG8_SA(b, h), kp, gA[h]); } \
        else { PG8_STAGE(PG8_SA(b, h), (kp) + (h) * hstep, voffA); } } while (0)
#define PG8_ROWS(dst, un) do { _Pragma("unroll") for (int _i = 0; _i < 2; ++_i) { int _R, _C; stage_rc(tid * 16 + _i * 8192, _R, _C); _Pragma("unroll") for (int _h = 0; _h < 2; ++_h) \
        dst[_h][_i] = (unsigned)g.rowidx[(un).pm * BM + _h * HALF + _R] * (unsigned)(K * 2) + (unsigned)_C * 2u; } } while (0)
#define PG8_LDA(dst, b, h) do { _Pragma("unroll") for (int m = 0; m < 4; ++m) _Pragma("unroll") for (int k = 0; k < 2; ++k) dst[m][k] = *(const LAS bf16x8*)(lds + PG8_SA(b, h) + aoff + m * 2048 + k * 1024); } while (0)
#define PG8_LDB(dst, b, h) do { _Pragma("unroll") for (int n = 0; n < 2; ++n) _Pragma("unroll") for (int k = 0; k < 2; ++k) dst[n][k] = *(const LAS bf16x8*)(lds + PG8_SB(b, h) + boff + n * 2048 + k * 1024); } while (0)
#define PG8_MMA(ai, bj, At, Bt) do { __builtin_amdgcn_s_setprio(1); _Pragma("unroll") for (int m = 0; m < 4; ++m) _Pragma("unroll") for (int n = 0; n < 2; ++n) _Pragma("unroll") for (int k = 0; k < 2; ++k) \
        acc[ai][bj][m][n] = __builtin_amdgcn_mfma_f32_16x16x32_bf16(Bt[n][k], At[m][k], acc[ai][bj][m][n], 0, 0, 0); __builtin_amdgcn_s_setprio(0); } while (0)
#define PG8_WAIT_V(n) asm volatile("s_waitcnt vmcnt(" #n ")" ::: "memory")
#define PG8_WAIT_L(n) asm volatile("s_waitcnt lgkmcnt(" #n ")" ::: "memory")
#define PG8_BAR __builtin_amdgcn_s_barrier()
#define PG8_SCHED __builtin_amdgcn_sched_barrier(0)
    Unit cur, nxt; int ui = 0;
    if (!S.next(0, cur)) return;
    f32x4 acc[2][2][4][2];
#pragma unroll
    for (int a = 0; a < 2; ++a)
#pragma unroll
        for (int b = 0; b < 2; ++b)
#pragma unroll
            for (int m = 0; m < 4; ++m)
#pragma unroll
                for (int n = 0; n < 2; ++n) acc[a][b][m][n] = (f32x4){0.f, 0.f, 0.f, 0.f};
    bf16x8 At[4][2], B0[2][2], B1[2][2];
    f32x4 pv[1] = {(f32x4){1.f, 1.f, 1.f, 1.f}};
    const char* cA = GATHER ? (const char*)g.A : (const char*)g.A + (size_t)cur.pm * tstep; const char* cB = (const char*)g.Bt + (size_t)cur.pn * tstep;
    if constexpr (GATHER) { PG8_ROWS(gA, cur); }
    PG8_STAGEB(PG8_SB(0, 0), cB, voffB); PG8_STAGEB(PG8_SB(0, 1), cB + hstep, voffB); PG8_ASTAGE(0, 0, cA, false); PG8_ASTAGE(0, 1, cA, false);
    if (wr == 1) PG8_BAR;
    PG8_WAIT_V(2); PG8_BAR;
    PG8_STAGEB(PG8_SB(1, 0), cB + kstep, voffB); PG8_ASTAGE(1, 0, cA + kstep, false); PG8_STAGEB(PG8_SB(1, 1), cB + hstep + kstep, voffB);
    PG8_WAIT_V(6); PG8_BAR;
    for (;;) {
        const bool has_next = S.next(ui + 1, nxt);
        const char* nA = has_next ? (GATHER ? (const char*)g.A : (const char*)g.A + (size_t)nxt.pm * tstep) : cA; const char* nB = has_next ? (const char*)g.Bt + (size_t)nxt.pn * tstep : cB;
        for (int t = 0; t < nt; t += 2) {
            const bool last = (t == nt - 2);
            const char* a1 = cA + (size_t)(t + 1) * kstep;
            const char* a2 = last ? nA : cA + (size_t)(t + 2) * kstep; const char* b2 = last ? nB : cB + (size_t)(t + 2) * kstep;
            const char* a3 = a2 + kstep; const char* b3 = b2 + kstep;
            if constexpr (Epi::HAS_PRE) { if (last) E.pre(cur, wr, fr, pv); }
            PG8_LDB(B0, 0, 0); PG8_LDB(B1, 0, 1); PG8_SCHED; PG8_LDA(At, 0, 0); PG8_ASTAGE(1, 1, a1, false);
            if constexpr (GATHER) { if (last && has_next) { PG8_ROWS(gA, nxt); } }
            PG8_WAIT_V(8); PG8_WAIT_L(0); PG8_BAR; PG8_MMA(0, 0, At, B0); PG8_MMA(0, 1, At, B1); PG8_BAR; PG8_SCHED;
            PG8_LDA(At, 0, 1); PG8_STAGEB(PG8_SB(0, 0), b2, voffB); PG8_STAGEB(PG8_SB(0, 1), b2 + hstep, voffB); PG8_ASTAGE(0, 0, a2, last);
            PG8_WAIT_V(8); PG8_WAIT_L(0); PG8_BAR; PG8_MMA(1, 0, At, B0); PG8_MMA(1, 1, At, B1); PG8_BAR; PG8_SCHED;
            PG8_LDB(B0, 1, 0); PG8_LDB(B1, 1, 1); PG8_SCHED; PG8_LDA(At, 1, 0); PG8_ASTAGE(0, 1, a2, last);
            PG8_WAIT_V(8); PG8_WAIT_L(0); PG8_BAR; PG8_MMA(0, 0, At, B0); PG8_MMA(0, 1, At, B1); PG8_BAR; PG8_SCHED;
            PG8_LDA(At, 1, 1); PG8_STAGEB(PG8_SB(1, 0), b3, voffB); PG8_STAGEB(PG8_SB(1, 1), b3 + hstep, voffB); PG8_ASTAGE(1, 0, a3, last);
            PG8_WAIT_V(8); PG8_WAIT_L(0); PG8_BAR; PG8_MMA(1, 0, At, B0); PG8_MMA(1, 1, At, B1); PG8_BAR; PG8_SCHED;
        }
        if (wr == 0) PG8_BAR;
        E(acc, cur, wr, wc, fr, fq, pv);
        if (DUP_ON(21)) { asm volatile("" ::: "memory"); E(acc, cur, wr, wc, fr, fq, pv); }
        if (!has_next) break;
#pragma unroll
        for (int a = 0; a < 2; ++a)
#pragma unroll
            for (int b = 0; b < 2; ++b)
#pragma unroll
                for (int m = 0; m < 4; ++m)
#pragma unroll
                    for (int n = 0; n < 2; ++n) acc[a][b][m][n] = (f32x4){0.f, 0.f, 0.f, 0.f};
        cur = nxt; cA = nA; cB = nB; ++ui;
        if (wr == 1) PG8_BAR;
    }
    PG8_WAIT_V(0);
    PG8_BAR;
#undef PG8_SA
#undef PG8_SB
#undef PG8_STAGE
#undef PG8_ASTAGE
#undef PG8_STAGEB
#undef PG8_ROWS
#undef PG8_LDA
#undef PG8_LDB
#undef PG8_MMA
#undef PG8_WAIT_V
#undef PG8_WAIT_L
#undef PG8_BAR
#undef PG8_SCHED
}
}

#define XB_TMO      128
#define XB_XCNT(j)  (256  + 64 * (j))
#define XB_XSUB(j)  (1280 + 64 * (j))
#define XB_XGEN(j)  (2304 + 64 * (j))
#define XB_TOP      3328
#define XB_TOPGEN   3392
#define XCD_BAR_WORDS 3456
#define XB_SPIN_CAP (1u << 18)
__device__ __forceinline__ unsigned xb_ld(unsigned* p)              { return __hip_atomic_load(p, __ATOMIC_RELAXED, __HIP_MEMORY_SCOPE_AGENT); }
__device__ __forceinline__ unsigned xb_add(unsigned* p, unsigned v) { return __hip_atomic_fetch_add(p, v, __ATOMIC_RELAXED, __HIP_MEMORY_SCOPE_AGENT); }
__device__ __forceinline__ unsigned xb_xcc_id() { return (unsigned)__builtin_amdgcn_s_getreg((3 << 11) | 20) & 0xFu; }
#define XB_SPIN(cond, bar) do { unsigned _sp = 0; while (cond) { \
    if ((++_sp & 255u) == 0u) { if (xb_ld(&(bar)[XB_TMO])) break; if (_sp > XB_SPIN_CAP) { atomicAdd(&(bar)[XB_TMO], 1u); break; } } } } while (0)
struct XcdBarrier { unsigned* bar; unsigned x; volatile LAS unsigned* st; };
__device__ __forceinline__ XcdBarrier xcd_barrier_post(unsigned* bar, volatile LAS unsigned* st) {
    XcdBarrier b; b.bar = bar; b.x = xb_xcc_id(); b.st = st;
    if (threadIdx.x == 0) (void)xb_add(&bar[XB_XCNT(b.x)], 1u);
    return b;
}
__device__ __forceinline__ void xcd_barrier_complete(unsigned* bar, unsigned x, unsigned& nloc, unsigned& nx) {
    const unsigned G = gridDim.x * gridDim.y * gridDim.z;
    unsigned sum, cnt, mine, sp = 0u;
    for (;;) {
        sum = 0u; cnt = 0u; mine = 0u;
#pragma unroll
        for (unsigned j = 0; j < 16; ++j) { const unsigned c = xb_ld(&bar[XB_XCNT(j)]); sum += c; cnt += (c > 0u) ? 1u : 0u; mine = (j == x) ? c : mine; }
        if (sum == G) break;
        __builtin_amdgcn_s_sleep(1);
        if ((++sp & 255u) == 0u) { if (xb_ld(&bar[XB_TMO])) break; if (sp > XB_SPIN_CAP) { atomicAdd(&bar[XB_TMO], 1u); break; } }
    }
    nloc = mine > 0u ? mine : 1u; nx = cnt > 0u ? cnt : 1u;
}
__device__ __noinline__ void xcd_barrier_impl(unsigned* bar_, unsigned x_, volatile LAS unsigned* st_) {
    XcdBarrier b; b.bar = bar_; b.x = x_; b.st = st_;
    asm volatile("s_waitcnt vmcnt(0)" ::: "memory");
    __syncthreads();
    if (threadIdx.x == 0) {
        unsigned* bar = b.bar;
        __builtin_amdgcn_s_waitcnt(0);
        unsigned nloc = b.st[0], nx = b.st[1];
        if (nloc == 0u) { xcd_barrier_complete(bar, b.x, nloc, nx); b.st[0] = nloc; b.st[1] = nx; }
        const unsigned old = xb_add(&bar[XB_XSUB(b.x)], 1u);
        const unsigned gen = old / nloc;
        if (old + 1u == (gen + 1u) * nloc) {
            __builtin_amdgcn_fence(__ATOMIC_RELEASE, "agent");
            asm volatile("s_waitcnt vmcnt(0)" ::: "memory");
            const unsigned og = xb_add(&bar[XB_TOP], 1u);
            const unsigned tg = og / nx;
            if (og + 1u == (tg + 1u) * nx) xb_add(&bar[XB_TOPGEN], 1u);
            else XB_SPIN(xb_ld(&bar[XB_TOPGEN]) == tg, bar);
            __builtin_amdgcn_fence(__ATOMIC_ACQUIRE, "agent");
            xb_add(&bar[XB_XGEN(b.x)], 1u);
            asm volatile("s_waitcnt vmcnt(0)" ::: "memory");
        } else {
            XB_SPIN(xb_ld(&bar[XB_XGEN(b.x)]) == gen, bar);
            __builtin_amdgcn_fence(__ATOMIC_ACQUIRE, "agent");
            asm volatile("s_waitcnt vmcnt(0)" ::: "memory");
        }
    }
    __syncthreads();
}

__device__ __forceinline__ void xcd_barrier(const XcdBarrier& b) { xcd_barrier_impl(b.bar, b.x, b.st); }

struct Params { const float* in[21]; float* out; unsigned char* ws; int lo, hi, li, pad; };
enum { I_X = 0, I_MEM, I_N1G, I_WINA, I_AQG, I_AKG, I_SINK, I_WINR, I_RDF, I_RDB, I_ROG, I_MNG, I_WMKV, I_CQG, I_CKG, I_WOUT, I_N2G, I_WR, I_WG, I_WU, I_WD };

template <bool NTS = true>
__device__ __forceinline__ void transpose_item(const float* src, int N, int K, bf16_t* dst, int drow0, int k0, int n0, LAS unsigned* scr, int lane, const float* kgain = nullptr) {
    f32x4 v[16];
    const int c4 = (lane & 15) * 4, kr = lane >> 4;
#pragma unroll
    for (int j = 0; j < 16; ++j) v[j] = __builtin_nontemporal_load((const f32x4*)(src + (size_t)(k0 + 4 * j + kr) * N + n0 + c4));
#pragma unroll
    for (int j = 0; j < 16; ++j) { const int k = 4 * j + kr; const float gk = kgain ? kgain[k0 + k] : 1.0f;
        scr[k * 33 + (lane & 15) * 2] = pk2(v[j][0] * gk, v[j][1] * gk); scr[k * 33 + (lane & 15) * 2 + 1] = pk2(v[j][2] * gk, v[j][3] * gk); }
    asm volatile("s_waitcnt lgkmcnt(0)" ::: "memory");
    const LAS unsigned short* sh = (const LAS unsigned short*)scr;
    const int kc = lane & 7;
#pragma unroll
    for (int jj = 0; jj < 8; ++jj) { const int n = (lane >> 3) + 8 * jj;
        unsigned h[8];
#pragma unroll
        for (int e = 0; e < 8; ++e) h[e] = sh[(8 * kc + e) * 66 + n];
        u32x4 w; w.x = h[0] | (h[1] << 16); w.y = h[2] | (h[3] << 16); w.z = h[4] | (h[5] << 16); w.w = h[6] | (h[7] << 16);
        if constexpr (NTS) __builtin_nontemporal_store(w, (u32x4*)(dst + (size_t)(drow0 + n) * K + k0 + 8 * kc)); else *(u32x4*)(dst + (size_t)(drow0 + n) * K + k0 + 8 * kc) = w; }
    asm volatile("s_waitcnt lgkmcnt(0)" ::: "memory");
}
__device__ __forceinline__ void phase_convert(const Params& p, bool moe_too, int part, LAS unsigned char* lds, int gw, int ngw, int wave, int lane) {
    LAS unsigned* scr = (LAS unsigned*)(lds + wave * 8448);
    unsigned char* ws = p.ws;
    constexpr int C0 = 2 * 1536, C1 = C0 + 2 * 2560, C2 = C1 + 4 * 512, C3 = C2 + 4 * 1024, C4 = C3 + 64 * 512, C5 = C4 + 64 * 512, C6 = C5 + 64 * 512;
    const int nj = part == 0 ? (moe_too ? C6 : C3) : (part == 1 ? 1536 + 2048 : C3 - 1536 - 2048);
    for (int j = gw; j < nj; j += ngw) {
        const int it = part == 0 ? j : (part == 1 ? (j < 1536 ? j : C1 + (j - 1536)) : (j < C1 - 1536 ? 1536 + j : C2 + (j - (C1 - 1536))));
        if (it < C0) { const int mat = it / 1536, r = it % 1536, kb = r / 48, nb = r % 48;
            transpose_item(p.in[I_WINA] + (size_t)mat * DM * ATT_W, ATT_W, DM, (bf16_t*)(ws + WS_WINA) + (size_t)mat * ATT_W * DM, 64 * nb, 64 * kb, 64 * nb, scr, lane, p.in[I_N1G] + (size_t)(2 * mat) * DM); }
        else if (it < C1) { const int q = it - C0, mat = q / 2560, r = q % 2560, kb = r / 80, nb = r % 80;
            transpose_item(p.in[I_WINR] + (size_t)mat * DM * RET_W, RET_W, DM, (bf16_t*)(ws + WS_WINR) + (size_t)mat * RET_W * DM, 64 * nb, 64 * kb, 64 * nb, scr, lane, p.in[I_N1G] + (size_t)(2 * mat + 1) * DM); }
        else if (it < C2) { const int q = it - C1, mat = q / 512, r = q % 512, kb = r / 16, nb = r % 16;
            transpose_item(p.in[I_WMKV] + (size_t)mat * DM * 1024, 1024, DM, (bf16_t*)(ws + WS_WMKV) + (size_t)mat * 1024 * DM, 64 * nb, 64 * kb, 64 * nb, scr, lane); }
        else if (it < C3) { const int q = it - C2, mat = q / 1024, r = q % 1024, kb = r / 32, nb = r % 32;
            transpose_item(p.in[I_WOUT] + (size_t)mat * DM * DM, DM, DM, (bf16_t*)(ws + WS_WOUT) + (size_t)mat * DM * DM, 64 * nb, 64 * kb, 64 * nb, scr, lane); }
        else if (it < C5) { const int up = it >= C4; const int q = it - (up ? C4 : C3), mat = q / 512, r = q % 512, kb = r / 16, nb = r % 16;
            const int n0 = 64 * nb, drow0 = 256 * (n0 >> 7) + 128 * up + (n0 & 127);
            transpose_item(p.in[up ? I_WU : I_WG] + (size_t)mat * DM * FF, FF, DM, (bf16_t*)(ws + WS_WGU) + (size_t)mat * 2048 * DM, drow0, 64 * kb, n0, scr, lane, p.in[I_N2G] + (size_t)(mat >> 4) * DM); }
        else { const int q = it - C5, mat = q / 512, r = q % 512, kb = r / 32, nb = r % 32;
            transpose_item(p.in[I_WD] + (size_t)mat * FF * DM, DM, FF, (bf16_t*)(ws + WS_WDN) + (size_t)mat * DM * FF, 64 * nb, 64 * kb, 64 * nb, scr, lane); }
    }
    bf16_t* memn = (bf16_t*)(ws + WS_MEMN);
    for (int r = gw; r < (part == 2 ? 0 : 4 * 512); r += ngw) { const int l = r >> 9, m = r & 511;
        const float* xr = p.in[I_MEM] + (size_t)m * DM; const float* gn = p.in[I_MNG] + l * DM;
        f32x4 v[8]; float ss = 0.f;
#pragma unroll
        for (int j = 0; j < 8; ++j) { v[j] = *(const f32x4*)(xr + 256 * j + 4 * lane); ss += (v[j][0] * v[j][0] + v[j][1] * v[j][1]) + (v[j][2] * v[j][2] + v[j][3] * v[j][3]); }
        const float rs = 1.0f / sqrtf(wave_sum(ss, lane) * (1.0f / DM) + EPS);
#pragma unroll
        for (int j = 0; j < 8; ++j) { const f32x4 gg = *(const f32x4*)(gn + 256 * j + 4 * lane); u32x2 w; w.x = pk2(v[j][0] * rs * gg[0], v[j][1] * rs * gg[1]); w.y = pk2(v[j][2] * rs * gg[2], v[j][3] * rs * gg[3]);
            *(u32x2*)(memn + (size_t)r * DM + 256 * j + 4 * lane) = w; }
    }
}

__device__ __forceinline__ void convert_moe_layer(const Params& p, int L, int i0, int i1, int w, int nw, LAS unsigned char* lds, int wave, int lane) {
    LAS unsigned* scr = (LAS unsigned*)(lds + wave * 8448);
    unsigned char* ws = p.ws;
    for (int ii = i0 + w; ii < i1; ii += nw) {
        const int i = ii < 8192 ? 16384 + ii : ii - 8192;
        if (i < 16384) { const int up = i >= 8192; const int q = i - up * 8192, mat = L * NEXP + q / 512, r = q % 512, kb = r / 16, nb = r % 16;
            const int n0 = 64 * nb, drow0 = 256 * (n0 >> 7) + 128 * up + (n0 & 127);
            transpose_item<false>(p.in[up ? I_WU : I_WG] + (size_t)mat * DM * FF, FF, DM, (bf16_t*)(ws + WS_WGU) + (size_t)mat * 2048 * DM, drow0, 64 * kb, n0, scr, lane, p.in[I_N2G] + (size_t)L * DM); }
        else { const int q = i - 16384, mat = L * NEXP + q / 512, r = q % 512, kb = r / 32, nb = r % 32;
            transpose_item(p.in[I_WD] + (size_t)mat * FF * DM, DM, FF, (bf16_t*)(ws + WS_WDN) + (size_t)mat * DM * FF, 64 * nb, 64 * kb, 64 * nb, scr, lane); }
    }
}

__device__ __forceinline__ void addrow_bf16(f32x4 (&v)[8], const u32x2 (&w)[8]) {
#pragma unroll
    for (int j = 0; j < 8; ++j) { v[j][0] += __uint_as_float(w[j].x << 16); v[j][1] += __uint_as_float(w[j].x & 0xffff0000u); v[j][2] += __uint_as_float(w[j].y << 16); v[j][3] += __uint_as_float(w[j].y & 0xffff0000u); }
}
__device__ __forceinline__ void combine_row(f32x4 (&v)[8], int iv, int b, const bf16_t* Y, int lane) {
    unsigned mask = (unsigned)__builtin_amdgcn_readfirstlane((int)(__ballot(iv >= 0) & 0xffffull));
    while (mask) {
        const int e0 = __builtin_ctz(mask); mask &= mask - 1u;
        const int c0 = __builtin_amdgcn_readlane(iv, e0);
        const bool two = mask != 0u;
        const int e1 = two ? __builtin_ctz(mask) : e0; if (two) mask &= mask - 1u;
        const int c1 = __builtin_amdgcn_readlane(iv, e1);
        const bf16_t* y0 = Y + (size_t)((b * NEXP + e0) * CAP + c0) * DM + 4 * lane;
        const bf16_t* y1 = Y + (size_t)((b * NEXP + e1) * CAP + c1) * DM + 4 * lane;
        u32x2 w0[8], w1[8];
#pragma unroll
        for (int j = 0; j < 8; ++j) { w0[j] = __builtin_nontemporal_load((const u32x2*)(y0 + 256 * j)); w1[j] = __builtin_nontemporal_load((const u32x2*)(y1 + 256 * j)); }
        addrow_bf16(v, w0);
        if (two) addrow_bf16(v, w1);
    }
}
__device__ __forceinline__ void xrow_finish(const f32x4 (&v)[8], int t, bool fin, float* outp, bf16_t* XB, float* rs1, int lane) {
    if (fin) {
#pragma unroll
        for (int j = 0; j < 8; ++j) __builtin_nontemporal_store(v[j], (f32x4*)(outp + (size_t)t * DM + 256 * j + 4 * lane));
    } else {
        float ss = 0.f;
#pragma unroll
        for (int j = 0; j < 8; ++j) { ss += (v[j][0] * v[j][0] + v[j][1] * v[j][1]) + (v[j][2] * v[j][2] + v[j][3] * v[j][3]);
            u32x2 w; w.x = pk2(v[j][0], v[j][1]); w.y = pk2(v[j][2], v[j][3]); *(u32x2*)(XB + (size_t)t * DM + 256 * j + 4 * lane) = w; }
        const float rs = 1.0f / sqrtf(wave_sum(ss, lane) * (1.0f / DM) + EPS);
        if (lane == 0) rs1[t] = rs;
    }
}
__device__ __forceinline__ void phase_norm1(const Params& p, int L, bool combine, bool do_norm, int gw, int ngw, int lane) {
    const int* inv = (const int*)(p.ws + WS_INV);
    const bf16_t* Y = (const bf16_t*)(p.ws + WS_Y); const bf16_t* XR = (const bf16_t*)(p.ws + WS_XR);
    bf16_t* XB = (bf16_t*)(p.ws + WS_H); float* rs1 = (float*)(p.ws + WS_RS1);
    for (int t = gw; t < TT; t += 2 * ngw) {
        const int t1 = t + ngw; const bool has1 = t1 < TT; const int t1c = has1 ? t1 : t;
        f32x4 v0[8], v1[8];
        if (!combine) {
#pragma unroll
            for (int j = 0; j < 8; ++j) { v0[j] = *(const f32x4*)(p.in[I_X] + (size_t)t * DM + 256 * j + 4 * lane); v1[j] = *(const f32x4*)(p.in[I_X] + (size_t)t1c * DM + 256 * j + 4 * lane); }
        } else {
            const int iv0 = inv[(size_t)t * 16 + (lane & 15)], iv1 = inv[(size_t)t1c * 16 + (lane & 15)];
            { u32x2 d0[8], d1[8];
#pragma unroll
              for (int j = 0; j < 8; ++j) { d0[j] = __builtin_nontemporal_load((const u32x2*)(XR + (size_t)t * DM + 256 * j + 4 * lane)); d1[j] = __builtin_nontemporal_load((const u32x2*)(XR + (size_t)t1c * DM + 256 * j + 4 * lane)); }
#pragma unroll
              for (int j = 0; j < 8; ++j) { v0[j] = (f32x4){0.f, 0.f, 0.f, 0.f}; v1[j] = (f32x4){0.f, 0.f, 0.f, 0.f}; }
              addrow_bf16(v0, d0); addrow_bf16(v1, d1); }
            combine_row(v0, iv0, t >> 13, Y, lane);
            combine_row(v1, iv1, t1c >> 13, Y, lane);
        }
        xrow_finish(v0, t, !do_norm, p.out, XB, rs1, lane);
        if (has1) xrow_finish(v1, t1, !do_norm, p.out, XB, rs1, lane);
    }
}

constexpr int RW_STRIDE = 4112, RW_LO = 16 * RW_STRIDE, RW_XCH = 2 * 16 * RW_STRIDE;
__device__ __forceinline__ void phase_router(const Params& p, int L, LAS unsigned char* lds, int gw, int ngw, int tid, int lane) {
    const int wave = __builtin_amdgcn_readfirstlane(tid >> 6);
    const float* wr = p.in[I_WR] + (size_t)L * DM * NEXP; const float* gn = p.in[I_N2G] + (size_t)L * DM;
    const bf16_t* XR = (const bf16_t*)(p.ws + WS_XR); float* rs2 = (float*)(p.ws + WS_RS2);
    float* aff = (float*)(p.ws + WS_AFF);
    const int i16 = lane & 15, g4 = lane >> 4, half = wave >> 2;
    LAS float* xch = (LAS float*)(lds + RW_XCH) + ((wave & 3) * 64 + lane) * 5;
    u32x4 xa[16];
#define RT_LOAD(dst, T0_, c0) do { int T_ = (T0_) + (wave & 3); T_ = T_ < TT / 16 ? T_ : TT / 16 - 1; const size_t ro_ = (size_t)(16 * T_ + i16) * DM + 1024 * half + 8 * g4; \
        _Pragma("unroll") for (int i = 0; i < 16; ++i) dst[i] = *(const u32x4*)(XR + ro_ + 32 * ((c0) + i)); } while (0)
#define RT_STEP(src, c0) do { _Pragma("unroll") for (int i = 0; i < 16; ++i) { float v[8]; \
            v[0] = __uint_as_float(src[i].x << 16); v[1] = __uint_as_float(src[i].x & 0xffff0000u); v[2] = __uint_as_float(src[i].y << 16); v[3] = __uint_as_float(src[i].y & 0xffff0000u); \
            v[4] = __uint_as_float(src[i].z << 16); v[5] = __uint_as_float(src[i].z & 0xffff0000u); v[6] = __uint_as_float(src[i].w << 16); v[7] = __uint_as_float(src[i].w & 0xffff0000u); \
            ss += ((v[0] * v[0] + v[1] * v[1]) + (v[2] * v[2] + v[3] * v[3])) + ((v[4] * v[4] + v[5] * v[5]) + (v[6] * v[6] + v[7] * v[7])); \
            const bf16x8 bh = *(const LAS bf16x8*)(wb + 64 * ((c0) + i)), bl = *(const LAS bf16x8*)(wb + RW_LO + 64 * ((c0) + i)); \
            acc = mfma16(u4_to_bf8(src[i]), bh, acc); acc = mfma16(u4_to_bf8(src[i]), bl, acc); } } while (0)
    int T0 = bidx() * 4;
    if (T0 < TT / 16) RT_LOAD(xa, T0, 0);
    for (int c = tid; c < DM; c += 512) { const float g = gn[c];
#pragma unroll
        for (int q = 0; q < 4; ++q) { const f32x4 w = *(const f32x4*)(wr + (size_t)c * 16 + 4 * q);
#pragma unroll
            for (int i = 0; i < 4; ++i) { const float val = w[i] * g; const unsigned hi = pk2(val, 0.f) & 0xffffu; const unsigned lo = pk2(val - __uint_as_float(hi << 16), 0.f) & 0xffffu;
                *(LAS unsigned short*)(lds + (4 * q + i) * RW_STRIDE + 2 * c) = (unsigned short)hi; *(LAS unsigned short*)(lds + RW_LO + (4 * q + i) * RW_STRIDE + 2 * c) = (unsigned short)lo; } }
    }
    __syncthreads();
    for (; T0 < TT / 16; T0 += (int)gridDim.x * 4) {
        int T = T0 + (wave & 3); const bool tile_ok = T < TT / 16; T = tile_ok ? T : TT / 16 - 1;
        const LAS unsigned char* wb = lds + i16 * RW_STRIDE + (1024 * half + 8 * g4) * 2;
        f32x4 acc = (f32x4){0.f, 0.f, 0.f, 0.f}; float ss = 0.f;
        { u32x4 xb[16];
          RT_LOAD(xb, T0, 16);
          RT_STEP(xa, 0);
          if (T0 + (int)gridDim.x * 4 < TT / 16) RT_LOAD(xa, T0 + (int)gridDim.x * 4, 0);
          RT_STEP(xb, 16); }
        ss = xadd16(ss); ss = xadd32(ss);
        if (half == 1) { xch[0] = acc[0]; xch[1] = acc[1]; xch[2] = acc[2]; xch[3] = acc[3]; xch[4] = ss; }
        __syncthreads();
        if (half == 0) {
            acc[0] += xch[0]; acc[1] += xch[1]; acc[2] += xch[2]; acc[3] += xch[3]; ss += xch[4];
            const float rs = 1.0f / sqrtf(ss * (1.0f / DM) + EPS);
            if (tile_ok && g4 == 0) __hip_atomic_store(rs2 + 16 * T + i16, rs, __ATOMIC_RELAXED, __HIP_MEMORY_SCOPE_AGENT);
#pragma unroll
            for (int r = 0; r < 4; ++r) {
                const float rst = __int_as_float(__builtin_amdgcn_ds_bpermute((4 * g4 + r) << 2, __float_as_int(rs)));
                const float lg = acc[r] * rst;
                float mx = lg; mx = fmaxf(mx, SHX(mx, 1)); mx = fmaxf(mx, SHX(mx, 2)); mx = fmaxf(mx, SHX(mx, 4)); mx = fmaxf(mx, SHX(mx, 8));
                const float pe = expf(lg - mx);
                float sm = pe; sm += SHX(sm, 1); sm += SHX(sm, 2); sm += SHX(sm, 4); sm += SHX(sm, 8);
                const int t = 16 * T + 4 * g4 + r;
                if (tile_ok) __hip_atomic_store(aff + ((size_t)((t >> 13) * NEXP + i16)) * SEQ + (t & (SEQ - 1)), pe / sm, __ATOMIC_RELAXED, __HIP_MEMORY_SCOPE_AGENT);
            }
        }
        __syncthreads();
    }
    __syncthreads();
}

__device__ __forceinline__ void router_publish(unsigned* cnt) {
    asm volatile("s_waitcnt vmcnt(0)" ::: "memory");
    __syncthreads();
    if (threadIdx.x == 0) __hip_atomic_fetch_add(cnt, 1u, __ATOMIC_RELAXED, __HIP_MEMORY_SCOPE_AGENT);
}
__device__ __forceinline__ void router_wait(unsigned* cnt, unsigned need, unsigned* tmo) {
    if (threadIdx.x < 64) {
        unsigned sp = 0;
        while ((unsigned)__builtin_amdgcn_readfirstlane((int)__hip_atomic_load(cnt, __ATOMIC_RELAXED, __HIP_MEMORY_SCOPE_AGENT)) < need) {
            __builtin_amdgcn_s_sleep(2);
            if ((++sp & 255u) == 0u) { if (__hip_atomic_load(tmo, __ATOMIC_RELAXED, __HIP_MEMORY_SCOPE_AGENT)) break; if (sp > (1u << 18)) { if (threadIdx.x == 0) atomicAdd(tmo, 1u); break; } } }
        __builtin_amdgcn_fence(__ATOMIC_ACQUIRE, "agent");
        asm volatile("s_waitcnt vmcnt(0)" ::: "memory");
    }
    __syncthreads();
}

__device__ __forceinline__ void phase_topk(const Params& p, LAS unsigned char* lds, int tid, int lane, int wave) {
    LAS unsigned* hist = (LAS unsigned*)lds;
    LAS unsigned* shw = (LAS unsigned*)(lds + 1024);
    const float* aff = (const float*)(p.ws + WS_AFF);
    int* rowidx = (int*)(p.ws + WS_ROWIDX); float* gatev = (float*)(p.ws + WS_GATEV); int* inv = (int*)(p.ws + WS_INV);
    const float* rs2 = (const float*)(p.ws + WS_RS2); float* rslot = (float*)(p.ws + WS_RSLOT);
    for (int u = bidx(); u < NB * NEXP; u += gridDim.x) {
        const int b = u >> 4, e = u & 15;
        unsigned key[16];
#pragma unroll
        for (int q = 0; q < 4; ++q) { const u32x4 w = *(const u32x4*)(aff + (size_t)u * SEQ + 16 * tid + 4 * q); key[4 * q] = w.x; key[4 * q + 1] = w.y; key[4 * q + 2] = w.z; key[4 * q + 3] = w.w; }
        unsigned prefix = 0u, mask = 0u, kk = CAP;
#pragma unroll 1
        for (int pass = 0; pass < 4; ++pass) {
            const int shift = 24 - 8 * pass;
            if (tid < 256) hist[tid] = 0u;
            __syncthreads();
#pragma unroll
            for (int i = 0; i < 16; ++i) if ((key[i] & mask) == prefix) __hip_atomic_fetch_add(&hist[(key[i] >> shift) & 255u], 1u, __ATOMIC_RELAXED, __HIP_MEMORY_SCOPE_WORKGROUP);
            __syncthreads();
            if (wave == 0) {
                const unsigned c0 = hist[255 - 4 * lane], c1 = hist[254 - 4 * lane], c2 = hist[253 - 4 * lane], c3 = hist[252 - 4 * lane];
                const unsigned tot = c0 + c1 + c2 + c3; unsigned incl = tot;
#pragma unroll
                for (int o = 1; o < 64; o <<= 1) { const unsigned y = shup_u(incl, o, lane); if (lane >= o) incl += y; }
                const unsigned excl = incl - tot;
                if (excl < kk && kk <= incl) { unsigned rem = kk - excl, bin;
                    if (rem <= c0) bin = 255 - 4 * lane; else { rem -= c0; if (rem <= c1) bin = 254 - 4 * lane; else { rem -= c1; if (rem <= c2) bin = 253 - 4 * lane; else { rem -= c2; bin = 252 - 4 * lane; } } }
                    shw[0] = bin; shw[1] = rem; }
            }
            __syncthreads();
            prefix |= shw[0] << shift; mask |= 255u << shift; kk = shw[1];
        }
        unsigned ne = 0;
#pragma unroll
        for (int i = 0; i < 16; ++i) ne += (key[i] == prefix) ? 1u : 0u;
        unsigned incl = ne;
#pragma unroll
        for (int o = 1; o < 64; o <<= 1) { const unsigned y = shup_u(incl, o, lane); if (lane >= o) incl += y; }
        if (lane == 63) shw[8 + wave] = incl;
        __syncthreads();
        unsigned eqbase = incl - ne;
#pragma unroll
        for (int w = 0; w < 8; ++w) eqbase += (w < wave) ? shw[8 + w] : 0u;
        unsigned selm = 0u, ns = 0u, er = eqbase;
#pragma unroll
        for (int i = 0; i < 16; ++i) { const bool gt = key[i] > prefix, eq = key[i] == prefix; const bool sel = gt || (eq && er < kk); er += eq ? 1u : 0u; selm |= sel ? (1u << i) : 0u; ns += sel ? 1u : 0u; }
        unsigned incl2 = ns;
#pragma unroll
        for (int o = 1; o < 64; o <<= 1) { const unsigned y = shup_u(incl2, o, lane); if (lane >= o) incl2 += y; }
        if (lane == 63) shw[16 + wave] = incl2;
        __syncthreads();
        unsigned cpos = incl2 - ns;
#pragma unroll
        for (int w = 0; w < 8; ++w) cpos += (w < wave) ? shw[16 + w] : 0u;
#pragma unroll
        for (int i = 0; i < 16; ++i) { const int tok = 16 * tid + i; const bool sel = (selm >> i) & 1u;
            if (sel) { rowidx[u * CAP + cpos] = b * SEQ + tok; gatev[u * CAP + cpos] = __uint_as_float(key[i]); rslot[u * CAP + cpos] = rs2[b * SEQ + tok]; }
            inv[((size_t)(b * SEQ + tok)) * 16 + e] = sel ? (int)cpos : -1;
            cpos += sel ? 1u : 0u; }
        __syncthreads();
    }
}

constexpr int AT_KS = 272, AT_VS = 288, AT_VOFF = 128 * AT_KS, AT_BUF = AT_VOFF + 128 * AT_VS;
__device__ __forceinline__ int xcd_vcu() { const int G = (int)gridDim.x, c = bidx(); return (G % 8 == 0) ? (c % 8) * (G / 8) + c / 8 : c; }
__device__ __forceinline__ float alibi_slope(int h) { return (h < 8) ? exp2f(-(float)(h + 1)) : exp2f(-0.5f * (float)(2 * (h - 8) + 1)); }
struct AttnU { int qrow0, krow_base, jb_lo, jb_hi, nq, qcol, kcol, vcol, ocol; float nslope2, m0; };
template <int MODE>
__device__ __forceinline__ void phase_attn_mode(const Params& p, int L, LAS unsigned char* lds, int tid, int lane, int wave) {
    const int li = L >> 1; const bool ret = (L & 1) != 0;
    const bf16_t* proj = (const bf16_t*)(p.ws + WS_PROJ); const int ldq = ret ? RET_W : ATT_W; const int qnh = ldq >> 7;
    const float* qpart = (const float*)(p.ws + WS_PART);
    const bf16_t* kvsrc = MODE == 0 ? proj : (const bf16_t*)(p.ws + WS_KVM); const int ldkv = MODE == 0 ? ldq : 4096;
    const float* kpart = MODE == 0 ? qpart : (const float*)(p.ws + WS_PARTM); const int knh = MODE == 0 ? qnh : 32;
    const float* qgain = MODE == 0 ? p.in[I_AQG] + li * 128 : p.in[I_CQG] + L * 128;
    const float* kgain = MODE == 0 ? p.in[I_AKG] + li * 128 : p.in[I_CKG] + L * 128;
    bf16_t* cat = (bf16_t*)(p.ws + WS_CAT);
    const int NU = MODE == 0 ? 1536 : 512, G = gridDim.x;
    const int i16 = lane & 15, g4 = lane >> 4;
    auto decode = [&](int u, AttnU& a) {
        if (MODE == 0) { const int hq = u % 12, n = (u / 12) & 63, b = u / 768, hk = hq / 3;
            a.qrow0 = b * SEQ + n * 128; a.krow_base = b * SEQ; a.jb_lo = n > 0 ? n - 1 : 0; a.jb_hi = n < 63 ? n + 1 : 63; a.nq = n;
            a.qcol = hq * 128; a.kcol = 1536 + hk * 128; a.vcol = 2048 + hk * 128; a.ocol = hq * 128;
            a.nslope2 = -alibi_slope(hq) * LOG2E; a.m0 = p.in[I_SINK][li * 12 + hq] * LOG2E; }
        else { const int hd = u & 3, n = (u >> 2) & 63, b = u >> 8;
            a.qrow0 = b * SEQ + n * 128; a.krow_base = L * 512 + b * MEML; a.jb_lo = 0; a.jb_hi = 1; a.nq = n;
            a.qcol = (ret ? 4608 : 2560) + hd * 128; a.kcol = L * 1024 + hd * 128; a.vcol = L * 1024 + 512 + hd * 128; a.ocol = 1536 + hd * 128;
            a.nslope2 = 0.f; a.m0 = -1e30f; }
    };
    u32x4 kraw[4], vraw[4]; f32x4 kpp[4];
    const unsigned lrow = (unsigned)(tid >> 4), lch = (unsigned)(tid & 15);
#define AT_PREFETCH(A, JB) do { const size_t kr0_ = (size_t)((A).krow_base + (JB) * 128); \
        _Pragma("unroll") for (int c = 0; c < 4; ++c) { const size_t kr_ = kr0_ + lrow + 32 * c; \
            kraw[c] = *(const u32x4*)(kvsrc + kr_ * ldkv + (A).kcol + 8 * lch); vraw[c] = *(const u32x4*)(kvsrc + kr_ * ldkv + (A).vcol + 8 * lch); \
            kpp[c] = *(const f32x4*)(kpart + (kr_ * knh + ((A).kcol >> 7)) * 4); } } while (0)
    int u = xcd_vcu(); if (u >= NU) return;
    AttnU cu, nu_; decode(u, cu);
    AT_PREFETCH(cu, cu.jb_lo);
    const f32x4 kga = *(const f32x4*)(kgain + 8 * lch), kgb = *(const f32x4*)(kgain + 8 * lch + 4);
    int bsel = 0;
    for (;;) {
        bf16x8 Qf[4];
        { const int t = cu.qrow0 + 16 * wave + i16; const f32x4 pp = *(const f32x4*)(qpart + ((size_t)t * qnh + (cu.qcol >> 7)) * 4);
          const float rq = __builtin_amdgcn_rsqf(((pp[0] + pp[1]) + (pp[2] + pp[3])) * (1.0f / 128.0f) + EPS) * QSCALE2;
#pragma unroll
          for (int ks = 0; ks < 4; ++ks) { const u32x4 raw = *(const u32x4*)(proj + (size_t)t * ldq + cu.qcol + 32 * ks + 8 * g4);
              const f32x4 ga = *(const f32x4*)(qgain + 32 * ks + 8 * g4), gb = *(const f32x4*)(qgain + 32 * ks + 8 * g4 + 4);
              u32x4 w; w.x = pk2(__uint_as_float(raw.x << 16) * rq * ga[0], __uint_as_float(raw.x & 0xffff0000u) * rq * ga[1]);
              w.y = pk2(__uint_as_float(raw.y << 16) * rq * ga[2], __uint_as_float(raw.y & 0xffff0000u) * rq * ga[3]);
              w.z = pk2(__uint_as_float(raw.z << 16) * rq * gb[0], __uint_as_float(raw.z & 0xffff0000u) * rq * gb[1]);
              w.w = pk2(__uint_as_float(raw.w << 16) * rq * gb[2], __uint_as_float(raw.w & 0xffff0000u) * rq * gb[3]);
              Qf[ks] = u4_to_bf8(w); } }
        f32x4 O[8];
#pragma unroll
        for (int d = 0; d < 8; ++d) O[d] = (f32x4){0.f, 0.f, 0.f, 0.f};
        float mrun = cu.m0, lrun = (MODE == 0 && g4 == 0) ? 1.0f : 0.0f;
        const int tq = cu.nq * 128 + 16 * wave + i16;
        const int un = u + G; const bool has_next = un < NU;
        if (has_next) decode(un, nu_);
        for (int jb = cu.jb_lo; jb <= cu.jb_hi; ++jb) {
            LAS unsigned char* ldb = lds + bsel * AT_BUF; bsel ^= 1;
#pragma unroll
            for (int c = 0; c < 4; ++c) { const float rk = __builtin_amdgcn_rsqf(((kpp[c][0] + kpp[c][1]) + (kpp[c][2] + kpp[c][3])) * (1.0f / 128.0f) + EPS);
                const u32x4 raw = kraw[c];
                u32x4 w; w.x = pk2(__uint_as_float(raw.x << 16) * rk * kga[0], __uint_as_float(raw.x & 0xffff0000u) * rk * kga[1]);
                w.y = pk2(__uint_as_float(raw.y << 16) * rk * kga[2], __uint_as_float(raw.y & 0xffff0000u) * rk * kga[3]);
                w.z = pk2(__uint_as_float(raw.z << 16) * rk * kgb[0], __uint_as_float(raw.z & 0xffff0000u) * rk * kgb[1]);
                w.w = pk2(__uint_as_float(raw.w << 16) * rk * kgb[2], __uint_as_float(raw.w & 0xffff0000u) * rk * kgb[3]);
                *(LAS u32x4*)(ldb + (lrow + 32 * c) * AT_KS + lch * 16) = w;
                *(LAS u32x4*)(ldb + AT_VOFF + (lrow + 32 * c) * AT_VS + lch * 16) = vraw[c]; }
            __syncthreads();
            if (jb < cu.jb_hi) { AT_PREFETCH(cu, jb + 1); } else if (has_next) { AT_PREFETCH(nu_, nu_.jb_lo); }
            const unsigned actm = (MODE == 1 || jb == cu.nq) ? 0xffu : (jb < cu.nq ? (0xffu << wave) & 0xffu : (0xffu >> (7 - wave)));
            f32x4 sc[8];
            float mx = -1e30f;
            const float fb = (float)(tq - jb * 128 - 4 * g4);
#pragma unroll
            for (int kt = 0; kt < 8; ++kt) {
                if ((actm >> kt) & 1u) { f32x4 a = (f32x4){0.f, 0.f, 0.f, 0.f};
#pragma unroll
                    for (int ks = 0; ks < 4; ++ks) { const bf16x8 kf = *(const LAS bf16x8*)(ldb + (16 * kt + i16) * AT_KS + (32 * ks + 8 * g4) * 2); a = mfma16(kf, Qf[ks], a); }
#pragma unroll
                    for (int r = 0; r < 4; ++r) { float v = a[r];
                        if (MODE == 0) { const float dist = fabsf(fb - (float)(16 * kt + r)); v = v + cu.nslope2 * dist; v = dist > 128.0f ? -1e30f : v; }
                        a[r] = v; mx = fmaxf(mx, v); }
                    sc[kt] = a; }
                else sc[kt] = (f32x4){-1e30f, -1e30f, -1e30f, -1e30f}; }
            mx = xmax16(mx); mx = xmax32(mx);
            const float mnew = fmaxf(mrun, mx), alpha = fast_exp2(mrun - mnew); mrun = mnew;
            float ls = 0.f;
#pragma unroll
            for (int kt = 0; kt < 8; ++kt) {
                if ((actm >> kt) & 1u) {
#pragma unroll
                    for (int r = 0; r < 4; ++r) { const float pv = fast_exp2(sc[kt][r] - mnew); sc[kt][r] = pv; ls += pv; } }
                else sc[kt] = (f32x4){0.f, 0.f, 0.f, 0.f}; }
            lrun = lrun * alpha + ls;
#pragma unroll
            for (int d = 0; d < 8; ++d) O[d] = O[d] * alpha;
            const LAS unsigned char* vb = ldb + AT_VOFF + (4 * g4 + (i16 >> 2)) * AT_VS + (4 * (i16 & 3)) * 2;
#pragma unroll
            for (int k2 = 0; k2 < 4; ++k2) {
                if ((actm >> (2 * k2)) & 3u) {
                    u32x4 w; w.x = pk2(sc[2 * k2][0], sc[2 * k2][1]); w.y = pk2(sc[2 * k2][2], sc[2 * k2][3]); w.z = pk2(sc[2 * k2 + 1][0], sc[2 * k2 + 1][1]); w.w = pk2(sc[2 * k2 + 1][2], sc[2 * k2 + 1][3]);
                    const bf16x8 pf = u4_to_bf8(w);
#pragma unroll
                    for (int d = 0; d < 8; ++d) { const s16x4 lo = tr_read(vb + (32 * k2) * AT_VS + 32 * d), hi = tr_read(vb + (32 * k2 + 16) * AT_VS + 32 * d);
                        O[d] = mfma16(cat4(lo, hi), pf, O[d]); } } }
        }
        float lt = lrun; lt = xadd16(lt); lt = xadd32(lt);
        const float il = 1.0f / lt;
        bf16_t* orow = cat + (size_t)(cu.qrow0 + 16 * wave + i16) * DM + cu.ocol + 4 * g4;
#pragma unroll
        for (int d = 0; d < 8; ++d) { u32x2 w; w.x = pk2(O[d][0] * il, O[d][1] * il); w.y = pk2(O[d][2] * il, O[d][3] * il); *(u32x2*)(orow + 16 * d) = w; }
        if (!has_next) break;
        u = un; cu = nu_;
    }
#undef AT_PREFETCH
}
__device__ __forceinline__ void phase_attn(const Params& p, int L, bool windowed, LAS unsigned char* lds, int tid, int lane, int wave) {
    if (windowed) { phase_attn_mode<0>(p, L, lds, tid, lane, wave); __syncthreads(); }
    phase_attn_mode<1>(p, L, lds, tid, lane, wave);
    __syncthreads();
}

#define GLD16(ub, lo) (*(const u32x4*)((const char*)(ub) + (lo)))
#define GLD8(ub, lo) (*(const u32x2*)((const char*)(ub) + (lo)))
__device__ __forceinline__ float log2_gamma(float x) { return -log1pf(expf(-x)) * LOG2E; }
constexpr int RT_KS = 288, RT_VS = 544;
__device__ __forceinline__ void phase_ret_kv(const Params& p, int L, LAS unsigned char* lds, int tid, int lane, int wave) {
    const int li = L >> 1; const char* proj = (const char*)(p.ws + WS_PROJ);
    bf16_t* kvc = (bf16_t*)(p.ws + WS_KVC);
    const int i16 = lane & 15, g4 = lane >> 4;
    constexpr int KIMG = 128 * RT_KS, VOFF = 2 * KIMG;
    const unsigned lk = (unsigned)((tid >> 4) * RET_W * 2 + (tid & 15) * 16), lv = (unsigned)((tid >> 5) * RET_W * 2 + (tid & 31) * 16);
    u32x4 kraw[4], vraw[8];
#define RK_PREFETCH(U) do { const int h_ = (U) % 6, n_ = ((U) / 6) & 63, b_ = (U) / 384; const char* pr_ = proj + ((size_t)b_ * SEQ + n_ * 128) * RET_W * 2; \
        _Pragma("unroll") for (int c = 0; c < 4; ++c) kraw[c] = GLD16(pr_ + (size_t)(32 * c) * RET_W * 2 + 1536 + h_ * 256, lk); \
        _Pragma("unroll") for (int c = 0; c < 8; ++c) vraw[c] = GLD16(pr_ + (size_t)(16 * c) * RET_W * 2 + 3072 + h_ * 512, lv); } while (0)
    int u = xcd_vcu(); if (u >= 768) return;
    RK_PREFETCH(u);
    for (;;) {
        const int h = u % 6, n = (u / 6) & 63, b = u / 384;
        const float lgf = log2_gamma(p.in[I_RDF][li * 6 + h]), lgb = log2_gamma(p.in[I_RDB][li * 6 + h]);
        __syncthreads();
#pragma unroll
        for (int c = 0; c < 4; ++c) { const int row = (tid >> 4) + 32 * c; const u32x4 raw = kraw[c];
#pragma unroll
            for (int dir = 0; dir < 2; ++dir) {
                const float z = fast_exp2(dir ? lgb * (float)row : lgf * (float)(127 - row));
                u32x4 w; w.x = pk2(__uint_as_float(raw.x << 16) * z, __uint_as_float(raw.x & 0xffff0000u) * z); w.y = pk2(__uint_as_float(raw.y << 16) * z, __uint_as_float(raw.y & 0xffff0000u) * z);
                w.z = pk2(__uint_as_float(raw.z << 16) * z, __uint_as_float(raw.z & 0xffff0000u) * z); w.w = pk2(__uint_as_float(raw.w << 16) * z, __uint_as_float(raw.w & 0xffff0000u) * z);
                *(LAS u32x4*)(lds + dir * KIMG + row * RT_KS + (tid & 15) * 16) = w; } }
#pragma unroll
        for (int c = 0; c < 8; ++c) *(LAS u32x4*)(lds + VOFF + ((tid >> 5) + 16 * c) * RT_VS + (tid & 31) * 16) = vraw[c];
        __syncthreads();
        const int un = u + (int)gridDim.x; const bool has_next = un < 768;
        if (has_next) RK_PREFETCH(un);
        const LAS unsigned char* vb = lds + VOFF + (4 * g4 + (i16 >> 2)) * RT_VS + (4 * (i16 & 3)) * 2 + 64 * wave;
#pragma unroll 1
        for (int dir = 0; dir < 2; ++dir) {
            f32x4 acc[8][2];
#pragma unroll
            for (int d = 0; d < 8; ++d) { acc[d][0] = (f32x4){0.f, 0.f, 0.f, 0.f}; acc[d][1] = (f32x4){0.f, 0.f, 0.f, 0.f}; }
            const LAS unsigned char* kb = lds + dir * KIMG + (4 * g4 + (i16 >> 2)) * RT_KS + (4 * (i16 & 3)) * 2;
#pragma unroll
            for (int ks = 0; ks < 4; ++ks) {
                bf16x8 bf[2];
#pragma unroll
                for (int et = 0; et < 2; ++et) bf[et] = cat4(tr_read(vb + (32 * ks) * RT_VS + 32 * et), tr_read(vb + (32 * ks + 16) * RT_VS + 32 * et));
#pragma unroll
                for (int d = 0; d < 8; ++d) { const bf16x8 af = cat4(tr_read(kb + (32 * ks) * RT_KS + 32 * d), tr_read(kb + (32 * ks + 16) * RT_KS + 32 * d));
                    acc[d][0] = mfma16(af, bf[0], acc[d][0]); acc[d][1] = mfma16(af, bf[1], acc[d][1]); }
            }
            bf16_t* o = kvc + ((size_t)((dir * 2 + b) * 6 + h) * 64 + n) * 32768;
#pragma unroll
            for (int et = 0; et < 2; ++et)
#pragma unroll
                for (int d = 0; d < 8; ++d) { u32x2 w; w.x = pk2(acc[d][et][0], acc[d][et][1]); w.y = pk2(acc[d][et][2], acc[d][et][3]);
                    *(u32x2*)(o + (size_t)(32 * wave + 16 * et + i16) * 128 + 16 * d + 4 * g4) = w; }
        }
        if (!has_next) break;
        u = un;
    }
    __syncthreads();
#undef RK_PREFETCH
}
__device__ __forceinline__ void phase_ret_scan(const Params& p, int L, int tid) {
    const int li = L >> 1; const bf16_t* kvc = (const bf16_t*)(p.ws + WS_KVC); bf16_t* st = (bf16_t*)(p.ws + WS_ST);
    for (int task = bidx() * 512 + tid; task < 24 * 4096; task += gridDim.x * 512) {
        const int seq = task >> 12, off = (task & 4095) * 8; const int h = seq % 6, dir = seq / 12;
        const float dec = fast_exp2(log2_gamma(dir ? p.in[I_RDB][li * 6 + h] : p.in[I_RDF][li * 6 + h]) * 128.0f);
        const size_t base = (size_t)seq * 64 * 32768 + off;
        float s[8];
#pragma unroll
        for (int j = 0; j < 8; ++j) s[j] = 0.f;
#pragma unroll 1
        for (int q0 = 0; q0 < 64; q0 += 32) {
            u32x4 kv[32];
#pragma unroll
            for (int i = 0; i < 32; ++i) { const int n = dir ? 63 - (q0 + i) : q0 + i; kv[i] = *(const u32x4*)(kvc + base + (size_t)n * 32768); }
#pragma unroll
            for (int i = 0; i < 32; ++i) { const int n = dir ? 63 - (q0 + i) : q0 + i;
                u32x4 w; w.x = pk2(s[0], s[1]); w.y = pk2(s[2], s[3]); w.z = pk2(s[4], s[5]); w.w = pk2(s[6], s[7]);
                *(u32x4*)(st + base + (size_t)n * 32768) = w;
                s[0] = s[0] * dec + __uint_as_float(kv[i].x << 16); s[1] = s[1] * dec + __uint_as_float(kv[i].x & 0xffff0000u);
                s[2] = s[2] * dec + __uint_as_float(kv[i].y << 16); s[3] = s[3] * dec + __uint_as_float(kv[i].y & 0xffff0000u);
                s[4] = s[4] * dec + __uint_as_float(kv[i].z << 16); s[5] = s[5] * dec + __uint_as_float(kv[i].z & 0xffff0000u);
                s[6] = s[6] * dec + __uint_as_float(kv[i].w << 16); s[7] = s[7] * dec + __uint_as_float(kv[i].w & 0xffff0000u); }
        }
    }
}
__device__ __forceinline__ void phase_ret_out(const Params& p, int L, LAS unsigned char* lds, int tid, int lane, int wave) {
    const int li = L >> 1; const char* proj = (const char*)(p.ws + WS_PROJ); const char* st = (const char*)(p.ws + WS_ST);
    char* cat = (char*)(p.ws + WS_CAT);
    const int i16 = lane & 15, g4 = lane >> 4;
    constexpr int QS = 272, KOFF = 128 * QS, VOFF = 2 * 128 * QS, ROFF = VOFF + 128 * RT_VS;
    LAS float* red = (LAS float*)(lds + ROFF);
    u32x4 sq[4], sk[4];
    const unsigned lo = (unsigned)((tid >> 4) * RET_W * 2 + (tid & 15) * 16);
    const unsigned lv = (unsigned)((tid >> 5) * RET_W * 2 + (tid & 31) * 16);
#define RO_PREFETCH(U) do { const int h_ = (U) % 6, n_ = ((U) / 6) & 63, b_ = (U) / 384; const char* pr_ = proj + ((size_t)b_ * SEQ + n_ * 128) * RET_W * 2; \
        _Pragma("unroll") for (int c = 0; c < 4; ++c) { sq[c] = GLD16(pr_ + (size_t)(32 * c) * RET_W * 2 + h_ * 256, lo); sk[c] = GLD16(pr_ + (size_t)(32 * c) * RET_W * 2 + 1536 + h_ * 256, lo); } } while (0)
    int u = bidx(); if (u >= 768) return;
    RO_PREFETCH(u);
    for (;;) {
        const int h = u % 6, n = (u / 6) & 63, b = u / 384;
        const int un = u + (int)gridDim.x; const bool has_next = un < 768;
        const float lgf = log2_gamma(p.in[I_RDF][li * 6 + h]), lgb = log2_gamma(p.in[I_RDB][li * 6 + h]);
        const size_t row0 = (size_t)b * SEQ + n * 128;
        const char* prow = proj + row0 * RET_W * 2;
        const unsigned lst = (unsigned)(i16 * 256 + g4 * 16);
        u32x4 stf[2][4][2];
#define RO_STATE(dir) do { const char* sp = st + (((size_t)(((dir) * 2 + b) * 6 + h) * 64 + n) * 32768 + (size_t)(32 * wave) * 128) * 2; \
        _Pragma("unroll") for (int ks = 0; ks < 4; ++ks) { stf[dir][ks][0] = GLD16(sp + 64 * ks, lst); stf[dir][ks][1] = GLD16(sp + 16 * 256 + 64 * ks, lst); } } while (0)
        RO_STATE(0);
        __syncthreads();
#pragma unroll
        for (int c = 0; c < 4; ++c) {
            *(LAS u32x4*)(lds + ((tid >> 4) + 32 * c) * QS + (tid & 15) * 16) = sq[c];
            *(LAS u32x4*)(lds + KOFF + ((tid >> 4) + 32 * c) * QS + (tid & 15) * 16) = sk[c]; }
        u32x4 sv[8];
#pragma unroll
        for (int c = 0; c < 8; ++c) sv[c] = GLD16(prow + (size_t)(16 * c) * RET_W * 2 + 3072 + h * 512, lv);
        __syncthreads();
        {
            f32x4 sc[8];
            { bf16x8 qf[4];
#pragma unroll
              for (int ks = 0; ks < 4; ++ks) qf[ks] = *(const LAS bf16x8*)(lds + (16 * wave + i16) * QS + (32 * ks + 8 * g4) * 2);
#pragma unroll
              for (int s8 = 0; s8 < 8; ++s8) { f32x4 a = (f32x4){0.f, 0.f, 0.f, 0.f};
#pragma unroll
                  for (int ks = 0; ks < 4; ++ks) { const bf16x8 kf = *(const LAS bf16x8*)(lds + KOFF + (16 * s8 + i16) * QS + (32 * ks + 8 * g4) * 2); a = mfma16(kf, qf[ks], a); }
                  sc[s8] = a; if (s8 & 1) asm volatile("" ::: "memory"); } }
            { int t = 16 * wave + i16 - 4 * g4; asm volatile("" : "+v"(t));
#pragma unroll
              for (int s8 = 0; s8 < 8; ++s8)
#pragma unroll
                  for (int r = 0; r < 4; ++r) { const int dl = t - (16 * s8 + r);
                      const float dcy = dl >= 0 ? fast_exp2(lgf * (float)dl) : fast_exp2(lgb * (float)(-dl)); sc[s8][r] = sc[s8][r] * dcy; } }
#pragma unroll
            for (int c = 0; c < 8; ++c) *(LAS u32x4*)(lds + VOFF + ((tid >> 5) + 16 * c) * RT_VS + (tid & 31) * 16) = sv[c];
            __syncthreads();
#pragma unroll
            for (int s8 = 0; s8 < 8; ++s8) { u32x2 w; w.x = pk2(sc[s8][0], sc[s8][1]); w.y = pk2(sc[s8][2], sc[s8][3]);
                *(LAS u32x2*)(lds + KOFF + (16 * wave + i16) * QS + (16 * s8 + 4 * g4) * 2) = w; }
            __syncthreads();
        }
        RO_STATE(1);
        f32x4 acc[2][8];
#pragma unroll
        for (int et = 0; et < 2; ++et)
#pragma unroll
            for (int tt = 0; tt < 8; ++tt) acc[et][tt] = (f32x4){0.f, 0.f, 0.f, 0.f};
        { const LAS unsigned char* qb = lds + i16 * QS + (8 * g4) * 2;
#pragma unroll
          for (int dir = 0; dir < 2; ++dir) {
#pragma unroll
            for (int ks = 0; ks < 4; ++ks) {
                const bf16x8 a0 = u4_to_bf8(stf[dir][ks][0]), a1 = u4_to_bf8(stf[dir][ks][1]);
#pragma unroll
                for (int tt = 0; tt < 8; ++tt) { const bf16x8 qf = *(const LAS bf16x8*)(qb + (16 * tt) * QS + 64 * ks);
                    acc[0][tt] = mfma16(a0, qf, acc[0][tt]); acc[1][tt] = mfma16(a1, qf, acc[1][tt]); }
                asm volatile("" ::: "memory");
            }
#pragma unroll
            for (int tt = 0; tt < 8; ++tt) { const float t = (float)(16 * tt + i16);
                const float f = dir == 0 ? fast_exp2(lgf * (t + 1.0f) - lgb * (128.0f - t)) : fast_exp2(lgb * (128.0f - t));
                acc[0][tt] = acc[0][tt] * f; acc[1][tt] = acc[1][tt] * f; }
          } }
        if (has_next) RO_PREFETCH(un);
        const unsigned lg = (unsigned)(i16 * RET_W * 2 + g4 * 8);
        u32x2 grv[8][2];
#pragma unroll
        for (int tt = 0; tt < 8; ++tt) { const char* gbase = prow + (size_t)(16 * tt) * RET_W * 2 + (3072 + h * 256 + 32 * wave) * 2;
            grv[tt][0] = GLD8(gbase, lg); grv[tt][1] = GLD8(gbase + 32, lg); }
        { const LAS unsigned char* vb = lds + VOFF + (4 * g4 + (i16 >> 2)) * RT_VS + (4 * (i16 & 3)) * 2 + 64 * wave;
          const LAS unsigned char* pb = lds + KOFF + i16 * QS + (4 * g4) * 2;
#pragma unroll 1
          for (int ks = 0; ks < 4; ++ks) {
              const bf16x8 v0 = cat4(tr_read(vb + (32 * ks) * RT_VS), tr_read(vb + (32 * ks + 16) * RT_VS));
              const bf16x8 v1 = cat4(tr_read(vb + (32 * ks) * RT_VS + 32), tr_read(vb + (32 * ks + 16) * RT_VS + 32));
#pragma unroll
              for (int tt = 0; tt < 8; ++tt) { const LAS unsigned char* pr = pb + (16 * tt) * QS + 64 * ks;
                  const u32x2 plo = *(const LAS u32x2*)pr, phi = *(const LAS u32x2*)(pr + 32);
                  u32x4 pw; pw.x = plo.x; pw.y = plo.y; pw.z = phi.x; pw.w = phi.y; const bf16x8 pf = u4_to_bf8(pw);
                  acc[0][tt] = mfma16(v0, pf, acc[0][tt]); acc[1][tt] = mfma16(v1, pf, acc[1][tt]); }
          } }
        const float kscale = 0.08838834764831845f;
#pragma unroll
        for (int tt = 0; tt < 8; ++tt) { float ss = 0.f;
#pragma unroll
            for (int et = 0; et < 2; ++et) { acc[et][tt] = acc[et][tt] * kscale; ss += (acc[et][tt][0] * acc[et][tt][0] + acc[et][tt][1] * acc[et][tt][1]) + (acc[et][tt][2] * acc[et][tt][2] + acc[et][tt][3] * acc[et][tt][3]); }
            ss = xadd16(ss); ss = xadd32(ss);
            if (g4 == 0) red[wave * 128 + 16 * tt + i16] = ss; }
        __syncthreads();
        const float* og = p.in[I_ROG] + (size_t)li * 1536 + h * 256 + 32 * wave;
        const f32x4 gn0 = *(const f32x4*)(og + 4 * g4), gn1 = *(const f32x4*)(og + 16 + 4 * g4);
        const unsigned lc = (unsigned)(i16 * DM * 2 + g4 * 8);
#pragma unroll
        for (int tt = 0; tt < 8; ++tt) { const int t = 16 * tt + i16; float tot = 0.f;
#pragma unroll
            for (int w = 0; w < 8; ++w) tot += red[w * 128 + t];
            const float rs = 1.0f / sqrtf(tot * (1.0f / 256.0f) + EPS);
            char* cbase = cat + (row0 + 16 * tt) * DM * 2 + (h * 256 + 32 * wave) * 2;
#pragma unroll
            for (int et = 0; et < 2; ++et) {
                const u32x2 gr = grv[tt][et];
                const f32x4 gn = et ? gn1 : gn0;
                const float y0 = acc[et][tt][0] * rs * gn[0] * silu_f(__uint_as_float(gr.x << 16)), y1 = acc[et][tt][1] * rs * gn[1] * silu_f(__uint_as_float(gr.x & 0xffff0000u));
                const float y2 = acc[et][tt][2] * rs * gn[2] * silu_f(__uint_as_float(gr.y << 16)), y3 = acc[et][tt][3] * rs * gn[3] * silu_f(__uint_as_float(gr.y & 0xffff0000u));
                u32x2 w; w.x = pk2(y0, y1); w.y = pk2(y2, y3);
                *(u32x2*)(cbase + 32 * et + lc) = w; } }
        if (!has_next) break;
        u = un;
    }
#undef RO_PREFETCH
#undef RO_STATE
    __syncthreads();
}

constexpr int NPH = 10;
constexpr int N_STEPS = 2 + DEPTH * NPH + 1;
__global__ void __launch_bounds__(512, 2) mega(Params p0) {
    extern __shared__ __attribute__((aligned(16))) unsigned char lds_raw[];
    LAS unsigned char* lds = (LAS unsigned char*)lds_raw;
    const int tid0 = threadIdx.x;
    const int G = gridDim.x; const int ngw = G * 8;
    volatile LAS unsigned* misc = (volatile LAS unsigned*)(lds + LDS_MISC);
    if (tid0 < 4) misc[tid0] = 0u;
    __syncthreads();
    unsigned* ctl = (unsigned*)(p0.ws + WS_CTL);
    XcdBarrier bar = xcd_barrier_post(ctl + 4096 + (size_t)p0.li * XCD_BAR_WORDS, misc);
    const int lo = p0.lo, hi = p0.hi; bool did = false; int L_ = 0;
    const bool defer_moe = (G >= 64) && (DEFER_MOE != 0);
    const bool merge_rt = (G == 256) && (lo == 0) && (hi == N_STEPS) && (MERGE_RT != 0);
    const bool split_cv = defer_moe && (G == 256) && (SPLIT_CV != 0);
#define STEP(k) if (lo <= (k) && (k) < hi && ((did ? (xcd_barrier(bar), 0) : 0), did = true, true))
#define FRESH() int tid = tid0; asm volatile("" : "+v"(tid)); const int lane = tid & 63, wave = __builtin_amdgcn_readfirstlane(tid >> 6); const int gw = bidx() * 8 + wave; const __attribute__((address_space(4))) Params* kp_ = (const __attribute__((address_space(4))) Params*)__builtin_amdgcn_kernarg_segment_ptr(); asm volatile("" : "+s"(kp_)); Params p; _Pragma("unroll") for (int i_ = 0; i_ < 21; ++i_) p.in[i_] = kp_->in[i_]; p.out = kp_->out; p.ws = kp_->ws; p.lo = 0; p.hi = 0; p.li = 0; p.pad = 0; unsigned char* ws = p.ws; (void)lane; (void)gw; (void)ws; int L = L_; asm volatile("" : "+s"(L)); const bool ret = (L & 1) != 0; const int li = L >> 1; (void)ret; (void)li

    STEP(0) { FRESH(); for (int rep_ = 0; rep_ < (DUP_ON(0) ? 2 : 1); ++rep_) { if (rep_) xcd_barrier(bar); if (PH_ON(0)) phase_convert(p, !defer_moe, split_cv ? 1 : 0, lds, gw, ngw, wave, lane); } if (PH_ON(2)) phase_norm1(p, 0, false, true, gw, ngw, lane); }
    STEP(1) if (PH_ON(1)) { FRESH();
        pg8::Gemm g{(const bf16_t*)(ws + WS_MEMN), (const bf16_t*)(ws + WS_WMKV), 2048, 4096, DM, nullptr};
        pg8::EpiProj E{(bf16_t*)(ws + WS_KVM), 4096, (float*)(ws + WS_PARTM), 32, 0x0F0F0F0Full, nullptr};
        if (split_cv) {
            pg8::DiagOrder S{bidx()};
            pg8::gemm_phase<pg8::EpiProj, pg8::DiagOrder, false>(lds, g, S, E);
            if (bidx() >= 32) phase_convert(p, false, 2, lds, (bidx() - 32) * 8 + wave, 224 * 8, wave, lane);
        } else {
            pg8::StaticOrder S; S.init(2048, 4096, G, bidx());
            for (int rep_ = 0; rep_ < (DUP_ON(1) ? 2 : 1); ++rep_) { if (rep_) xcd_barrier(bar); pg8::gemm_phase<pg8::EpiProj, pg8::StaticOrder, false>(lds, g, S, E); }
        }
    }
#pragma unroll 1
    for (int Lo = 0; Lo < NLAYERS; ++Lo) {
        const int base = 2 + Lo * NPH; const bool ret = (Lo & 1) != 0; L_ = Lo;
        if (Lo > 0) { STEP(base + 0) { FRESH(); if (PH_ON(2)) phase_norm1(p, L, true, true, gw, ngw, lane); if (DUP_ON(2)) { xcd_barrier(bar); phase_norm1(p, L, true, true, gw, ngw, lane); } } }
        STEP(base + 1) if (PH_ON(3)) { FRESH();
            const int N = ret ? RET_W : ATT_W;
            pg8::Gemm g{(const bf16_t*)(ws + WS_H), ret ? (const bf16_t*)(ws + WS_WINR) + (size_t)li * RET_W * DM : (const bf16_t*)(ws + WS_WINA) + (size_t)li * ATT_W * DM, TT, N, DM, nullptr};
            pg8::StaticOrder S; S.init(TT, N, G, bidx());
            pg8::EpiProj E{(bf16_t*)(ws + WS_PROJ), N, (float*)(ws + WS_PART), N >> 7, ret ? 0xF000000000ull : 0xF0FFFFull, (const float*)(ws + WS_RS1)};
            for (int rep_ = 0; rep_ < (DUP_ON(3) ? 2 : 1); ++rep_) { if (rep_) xcd_barrier(bar); pg8::gemm_phase<pg8::EpiProj, pg8::StaticOrder, false>(lds, g, S, E); }
        }
        if (!ret) {
            STEP(base + 2) { FRESH(); if (PH_ON(4)) phase_attn(p, L, true, lds, tid, lane, wave); if (DUP_ON(4)) { xcd_barrier(bar); phase_attn(p, L, true, lds, tid, lane, wave); } }
        } else {
            STEP(base + 2) { FRESH(); if (PH_ON(5)) phase_ret_kv(p, L, lds, tid, lane, wave); if (DUP_ON(5)) { xcd_barrier(bar); phase_ret_kv(p, L, lds, tid, lane, wave); } if (PH_ON(14)) phase_attn(p, L, false, lds, tid, lane, wave); if (DUP_ON(14)) { xcd_barrier(bar); phase_attn(p, L, false, lds, tid, lane, wave); } }
            STEP(base + 3) { FRESH(); for (int rep_ = 0; rep_ < (DUP_ON(6) ? 2 : 1); ++rep_) { if (rep_) xcd_barrier(bar); if (PH_ON(6)) phase_ret_scan(p, L, tid); } }
            STEP(base + 4) { FRESH(); for (int rep_ = 0; rep_ < (DUP_ON(7) ? 2 : 1); ++rep_) { if (rep_) xcd_barrier(bar); if (PH_ON(7)) phase_ret_out(p, L, lds, tid, lane, wave); } }
        }
        STEP(base + 5) if (PH_ON(8)) { FRESH();
            pg8::Gemm g{(const bf16_t*)(ws + WS_CAT), (const bf16_t*)(ws + WS_WOUT) + (size_t)L * DM * DM, TT, DM, DM, nullptr};
            pg8::StaticOrder S; S.init(TT, DM, G, bidx());
            pg8::EpiDelta E{(bf16_t*)(ws + WS_XR), DM, (const bf16_t*)(ws + WS_H)};
            for (int rep_ = 0; rep_ < (DUP_ON(8) ? 2 : 1); ++rep_) { if (rep_) xcd_barrier(bar); pg8::gemm_phase<pg8::EpiDelta, pg8::StaticOrder, false>(lds, g, S, E); }
        }
        STEP(base + 6) { FRESH(); for (int rep_ = 0; rep_ < (DUP_ON(9) ? 2 : 1); ++rep_) { if (rep_) xcd_barrier(bar); if (PH_ON(9)) phase_router(p, L, lds, gw, ngw, tid, lane); }
            if (merge_rt) router_publish(ctl + 8192 + (L * 2 + (bidx() >> 7)) * 64); }
        if (merge_rt ? (lo <= base + 6 && base + 6 < hi) : (lo <= base + 7 && base + 7 < hi && ((did ? (xcd_barrier(bar), 0) : 0), did = true, true))) { FRESH();
            if (merge_rt && bidx() < 32) router_wait(ctl + 8192 + (L * 2 + (bidx() >> 4)) * 64, 128u, ctl + 4096 + XB_TMO);
            for (int rep_ = 0; rep_ < (DUP_ON(10) ? 2 : 1); ++rep_) { if (rep_) xcd_barrier(bar); if (PH_ON(10)) phase_topk(p, lds, tid, lane, wave); }
            if (defer_moe) {
                const int nA = (G == 256) ? 2560 : 0, nB = 24576 - nA;
                if (bidx() >= 32) convert_moe_layer(p, L, 0, nB, (bidx() - 32) * 8 + wave, (G - 32) * 8, lds, wave, lane);
                else if (nA) convert_moe_layer(p, L, nB, 24576, bidx() * 8 + wave, 256, lds, wave, lane);
            } }
        STEP(base + 8) if (PH_ON(11)) { FRESH();
            pg8::Gemm g{(const bf16_t*)(ws + WS_XR), (const bf16_t*)(ws + WS_WGU) + (size_t)L * NEXP * 2048 * DM, NSLOT, 2048, DM, (const int*)(ws + WS_ROWIDX)};
            pg8::MoeOrder S{G, bidx()};
            pg8::EpiSwiglu E{(bf16_t*)(ws + WS_HID), (const float*)(ws + WS_RSLOT)};
            for (int rep_ = 0; rep_ < (DUP_ON(11) ? 2 : 1); ++rep_) { if (rep_) xcd_barrier(bar); pg8::gemm_phase<pg8::EpiSwiglu, pg8::MoeOrder, true, MOE_B_AUX>(lds, g, S, E); }
        }
        STEP(base + 9) if (PH_ON(12)) { FRESH();
            pg8::Gemm g{(const bf16_t*)(ws + WS_HID), (const bf16_t*)(ws + WS_WDN) + (size_t)L * NEXP * DM * FF, NSLOT, DM, FF, nullptr};
            pg8::MoeOrder S{G, bidx()};
            pg8::EpiDown E{(bf16_t*)(ws + WS_Y), (const float*)(ws + WS_GATEV)};
            for (int rep_ = 0; rep_ < (DUP_ON(12) ? 2 : 1); ++rep_) { if (rep_) xcd_barrier(bar); pg8::gemm_phase<pg8::EpiDown, pg8::MoeOrder, false, MOE_B_AUX>(lds, g, S, E); }
        }
    }
    if (DUP_ON(20) && hi > 5) { for (int i_ = 0; i_ < 40; ++i_) xcd_barrier(bar); }
    L_ = 0;
    STEP(2 + DEPTH * NPH) { FRESH(); if (PH_ON(13)) phase_norm1(p, 0, true, false, gw, ngw, lane); }
#undef STEP
}

extern "C" void kernel_launch(void* const* d_in, const int* in_sizes, int n_in, void* d_out, int out_size, void* d_ws, size_t ws_size, hipStream_t stream) {
    static int grid = 0;
    if (grid == 0) {
        if (n_in != 21 || out_size != TT * DM || ws_size < WS_END) { fprintf(stderr, "kernel_launch: unexpected shapes (n_in %d out %d ws %zu)\n", n_in, out_size, ws_size); grid = -1; return; }
        int dev = 0, cus = 0, per_cu = 0;
        if (hipGetDevice(&dev) != hipSuccess || hipDeviceGetAttribute(&cus, hipDeviceAttributeMultiprocessorCount, dev) != hipSuccess) { grid = -1; return; }
        if (hipFuncSetAttribute((const void*)mega, hipFuncAttributeMaxDynamicSharedMemorySize, LDS_BYTES) != hipSuccess) { fprintf(stderr, "kernel_launch: hipFuncSetAttribute failed\n"); grid = -1; return; }
        if (hipOccupancyMaxActiveBlocksPerMultiprocessor(&per_cu, (const void*)mega, 512, LDS_BYTES) != hipSuccess || per_cu < 1) fprintf(stderr, "kernel_launch: occupancy query says %d\n", per_cu);
        (void)hipGetLastError();
        grid = cus;
    }
    if (grid < 0) return;
    (void)hipMemsetAsync((char*)d_ws + WS_CTL, 0, MK_FUSED ? (size_t)65536 : CTL_BYTES, stream);
    Params a{};
    for (int i = 0; i < 21; ++i) a.in[i] = (const float*)d_in[i];
    a.out = (float*)d_out; a.ws = (unsigned char*)d_ws; a.pad = 0;
#if MK_FUSED
    a.lo = 0; a.hi = N_STEPS; a.li = 0;
    hipLaunchKernelGGL(mega, dim3(grid), dim3(512), LDS_BYTES, stream, a);
#else
    int li = 0;
    for (int s = 0; s < N_STEPS; ++s) {
        if (s >= 2 && s < 2 + DEPTH * NPH) { const int L = (s - 2) / NPH, ph = (s - 2) % NPH; if ((L & 1) == 0 && (ph == 3 || ph == 4)) continue; }
        a.lo = s; a.hi = s + 1; a.li = li++;
        hipLaunchKernelGGL(mega, dim3(grid), dim3(512), LDS_BYTES, stream, a);
    }
#endif
}
```

```cpp
#include <hip/hip_runtime.h>
#include <cstdio>
#include <cstdint>

#define LAS __attribute__((address_space(3)))
typedef unsigned short bf16_t;
typedef short bf16x8 __attribute__((ext_vector_type(8)));
typedef short s16x4 __attribute__((ext_vector_type(4)));
typedef float f32x4 __attribute__((ext_vector_type(4)));
typedef float f32x2 __attribute__((ext_vector_type(2)));
typedef unsigned u32x4 __attribute__((ext_vector_type(4)));
typedef unsigned u32x2 __attribute__((ext_vector_type(2)));

#ifndef PHMASK
#define PHMASK 0xFFFFFFFFu
#endif
#ifndef PHMASK2
#define PHMASK2 0xFFFFFFFFu
#endif
#define PH_ON(k) ((((PHMASK) >> (k)) & 1u) && (L_ < 2 || (((PHMASK2) >> (k)) & 1u)))
#ifndef DUPMASK
#define DUPMASK 0u
#endif
#define DUP_ON(k) (((DUPMASK) >> (k)) & 1u)
#ifndef MERGE_RT
#define MERGE_RT 1
#endif
#ifndef MOE_B_AUX
#define MOE_B_AUX 0
#endif
#ifndef SPLIT_CV
#define SPLIT_CV 1
#endif
#ifndef DEFER_MOE
#define DEFER_MOE 1
#endif
#ifndef NLAYERS
#define NLAYERS 4
#endif
#ifndef MK_FUSED
#define MK_FUSED 1
#endif

constexpr int NB = 2, SEQ = 8192, DM = 2048, TT = NB * SEQ, DEPTH = 4;
constexpr int NEXP = 16, FF = 1024, CAP = 1024, NSLOT = NB * NEXP * CAP;
constexpr int ATT_W = 3072, RET_W = 5120, MEML = 256;
constexpr float EPS = 1e-6f;
constexpr float LOG2E = 1.4426950408889634f;
constexpr float QSCALE2 = 0.08838834764831845f * 1.4426950408889634f;

constexpr size_t MiB = (size_t)1 << 20;
constexpr size_t WS_CTL = 0, CTL_BYTES = 1 * MiB;
constexpr size_t WS_WINA = 1 * MiB;
constexpr size_t WS_WINR = 25 * MiB;
constexpr size_t WS_WMKV = 65 * MiB;
constexpr size_t WS_WOUT = 81 * MiB;
constexpr size_t WS_WGU = 113 * MiB;
constexpr size_t WS_WDN = 625 * MiB;
constexpr size_t WS_MEMN = 881 * MiB;
constexpr size_t WS_KVM = 889 * MiB;
constexpr size_t WS_PARTM = 905 * MiB;
constexpr size_t WS_H = 906 * MiB;
constexpr size_t WS_PROJ = 970 * MiB;
constexpr size_t WS_PART = 1130 * MiB;
constexpr size_t WS_CAT = 1140 * MiB;
constexpr size_t WS_KVC = 1204 * MiB;
constexpr size_t WS_ST = WS_KVC;
constexpr size_t WS_HID = 1396 * MiB;
constexpr size_t WS_Y = 1460 * MiB;
constexpr size_t WS_AFF = 1588 * MiB;
constexpr size_t WS_ROWIDX = 1589 * MiB;
constexpr size_t WS_GATEV = 1589 * MiB + 256 * 1024;
constexpr size_t WS_RSLOT = 1589 * MiB + 512 * 1024;
constexpr size_t WS_RS1 = 1589 * MiB + 640 * 1024;
constexpr size_t WS_RS2 = 1589 * MiB + 704 * 1024;
constexpr size_t WS_INV = 1590 * MiB;
constexpr size_t WS_XR = 1591 * MiB;
constexpr size_t WS_END = 1655 * MiB;

constexpr int LDS_BYTES = 160 * 1024;
constexpr int LDS_MISC = LDS_BYTES - 256;

__device__ __forceinline__ float bf2f(unsigned short b) { return __uint_as_float(((unsigned)b) << 16); }
typedef __bf16 bf16x2_t __attribute__((ext_vector_type(2)));
__device__ __forceinline__ unsigned pk2(float lo, float hi) { const f32x2 v = {lo, hi}; const bf16x2_t b = __builtin_convertvector(v, bf16x2_t); return __builtin_bit_cast(unsigned, b); }
__device__ __forceinline__ float shx_f(float v, int o, int lane) { return __int_as_float(__builtin_amdgcn_ds_bpermute((lane ^ o) << 2, __float_as_int(v))); }
__device__ __forceinline__ unsigned shup_u(unsigned v, int o, int lane) { return (unsigned)__builtin_amdgcn_ds_bpermute((lane - o) << 2, (int)v); }
#define SHX(v, o) shx_f((v), (o), lane)
__device__ __forceinline__ float xadd16(float x) { const u32x2 r = __builtin_amdgcn_permlane16_swap(__float_as_uint(x), __float_as_uint(x), false, false); return __uint_as_float(r[0]) + __uint_as_float(r[1]); }
__device__ __forceinline__ float xadd32(float x) { const u32x2 r = __builtin_amdgcn_permlane32_swap(__float_as_uint(x), __float_as_uint(x), false, false); return __uint_as_float(r[0]) + __uint_as_float(r[1]); }
__device__ __forceinline__ float xmax16(float x) { const u32x2 r = __builtin_amdgcn_permlane16_swap(__float_as_uint(x), __float_as_uint(x), false, false); return fmaxf(__uint_as_float(r[0]), __uint_as_float(r[1])); }
__device__ __forceinline__ float xmax32(float x) { const u32x2 r = __builtin_amdgcn_permlane32_swap(__float_as_uint(x), __float_as_uint(x), false, false); return fmaxf(__uint_as_float(r[0]), __uint_as_float(r[1])); }
__device__ __forceinline__ float wave_sum(float v, int lane) {
#pragma unroll
    for (int o = 1; o < 64; o <<= 1) v += SHX(v, o);
    return v;
}
__device__ __forceinline__ int bidx() { int b = (int)blockIdx.x; asm volatile("" : "+s"(b)); return b; }
__device__ __forceinline__ float fast_exp2(float x) { return __builtin_amdgcn_exp2f(x); }
__device__ __forceinline__ float silu_f(float x) { return x * __builtin_amdgcn_rcpf(1.0f + __builtin_amdgcn_exp2f(-x * LOG2E)); }
__device__ __forceinline__ s16x4 tr_read(const LAS unsigned char* p) {
    typedef short v4i16_t __attribute__((ext_vector_type(4)));
    return __builtin_bit_cast(s16x4, __builtin_amdgcn_ds_read_tr16_b64_v4i16((LAS v4i16_t*)p));
}
__device__ __forceinline__ bf16x8 cat4(s16x4 lo, s16x4 hi) { bf16x8 r; r[0] = lo[0]; r[1] = lo[1]; r[2] = lo[2]; r[3] = lo[3]; r[4] = hi[0]; r[5] = hi[1]; r[6] = hi[2]; r[7] = hi[3]; return r; }
__device__ __forceinline__ bf16x8 u4_to_bf8(u32x4 w) { return __builtin_bit_cast(bf16x8, w); }
__device__ __forceinline__ f32x4 mfma16(bf16x8 a, bf16x8 b, f32x4 c) { return __builtin_amdgcn_mfma_f32_16x16x32_bf16(a, b, c, 0, 0, 0); }

namespace pg8 {
constexpr int BM = 256, BK = 64, HALF = 128, HTB = HALF * BK * 2, STAGE_BYTES = 8 * HTB, NXCD = 8, WGM = 8;
__host__ __device__ __forceinline__ int lds_byte(int r, int c) { const int st = (r >> 4) * 2 + (c >> 5), rr = r & 15, cc = c & 31, ob = rr * 64 + cc * 2; return st * 1024 + (ob ^ (((ob >> 9) & 1) << 5)); }
__host__ __device__ __forceinline__ void stage_rc(int b, int& R, int& C) { const int st = b / 1024, sb = b % 1024, swz = sb ^ (((sb >> 9) & 1) << 5); R = (st >> 1) * 16 + swz / 64; C = (st & 1) * 32 + (swz % 64) / 2; }
__host__ __device__ __forceinline__ int perm32(int rho) { const int n = rho >> 4, i = rho & 15; return 8 * (i >> 2) + 4 * n + (i & 3); }

struct Unit { int pm, pn; };
struct Gemm { const bf16_t* A; const bf16_t* Bt; int M, N, K; const int* rowidx; };

struct StaticOrder {
    int nM, nN, nwg, G, c;
    __device__ void init(int M, int N, int G_, int c_) { nM = M / BM; nN = N / BM; nwg = nM * nN; G = G_; c = c_; }
    __device__ bool next(int i, Unit& u) const {
        const long L = (long)i * G + c; if (L >= nwg) return false;
        int wgid = (int)L; { const int q = nwg / NXCD, r = nwg % NXCD, xcd = wgid % NXCD, off = wgid / NXCD; wgid = (xcd < r ? xcd * (q + 1) : r * (q + 1) + (xcd - r) * q) + off; }
        const int nig = WGM * nN, gid = wgid / nig, fm = gid * WGM, gsz = (nM - fm) < WGM ? (nM - fm) : WGM;
        u.pm = fm + ((wgid % nig) % gsz); u.pn = (wgid % nig) / gsz; return true;
    }
};
struct DiagOrder {
    int c;
    __device__ bool next(int i, Unit& u) const { if (i != 0 || c >= 32) return false; const int l = c >> 3, j = c & 7; u.pm = 2 * l + (j >> 2); u.pn = 4 * l + (j & 3); return true; }
};
struct MoeOrder {
    int G, c;
    __device__ bool next(int i, Unit& u) const {
        const long v = (long)i * G + c; if (v >= 1024) return false;
        int uu = (int)v;
        if (G == 256) { const int x = c & 7, j = c >> 3; uu = (i * 8 + x) * 32 + j; }
        const int grp = uu >> 5, j = uu & 31, e = grp >> 1, b = grp & 1;
        u.pm = (b * NEXP + e) * 4 + (j >> 3); u.pn = e * 8 + (j & 7); return true;
    }
};

struct EpiProj {
    static constexpr bool PERM = true;
    bf16_t* O; int ldc; float* part; int nh; unsigned long long need; const float* rowscale;
    static constexpr bool HAS_PRE = true;
    __device__ __forceinline__ void pre(const Unit& u, int wr, int fr, f32x4 (&pv)[1]) const {
        const int row0 = u.pm * BM + wr * 64 + fr;
#pragma unroll
        for (int q = 0; q < 4; ++q) pv[0][q] = rowscale ? rowscale[row0 + q * 16] : 1.0f; }
    __device__ __forceinline__ void operator()(const f32x4 (&acc)[2][2][4][2], const Unit& u, int wr, int wc, int fr, int fq, const f32x4 (&pv)[1]) const {
        const int row0 = u.pm * BM + wr * 64 + fr, col0 = u.pn * BM + wc * 32 + 8 * fq;
        const bool nd0 = (need >> (u.pn * 2)) & 1ull, nd1 = (need >> (u.pn * 2 + 1)) & 1ull;
        f32x4 pw; pw[0] = rowscale ? rowscale[row0 + HALF] : 1.0f; pw[1] = rowscale ? rowscale[row0 + HALF + 16] : 1.0f; pw[2] = rowscale ? rowscale[row0 + HALF + 32] : 1.0f; pw[3] = rowscale ? rowscale[row0 + HALF + 48] : 1.0f;
#pragma unroll
        for (int ai = 0; ai < 2; ++ai)
#pragma unroll
            for (int m = 0; m < 4; ++m) { const int row = row0 + ai * HALF + m * 16; bf16_t* rowp = O + (size_t)row * ldc + col0; const float rsc = ai ? pw[m] : pv[0][m];
#pragma unroll
                for (int bj = 0; bj < 2; ++bj) { const f32x4 v0 = acc[ai][bj][m][0] * rsc, v1 = acc[ai][bj][m][1] * rsc;
                    u32x4 w; w.x = pk2(v0[0], v0[1]); w.y = pk2(v0[2], v0[3]); w.z = pk2(v1[0], v1[1]); w.w = pk2(v1[2], v1[3]);
                    *(u32x4*)(rowp + bj * HALF) = w;
                    if (bj ? nd1 : nd0) {
                        float ss = (v0[0] * v0[0] + v0[1] * v0[1]) + (v0[2] * v0[2] + v0[3] * v0[3]) + (v1[0] * v1[0] + v1[1] * v1[1]) + (v1[2] * v1[2] + v1[3] * v1[3]);
                        { const int lane = fq * 16 + fr; ss = xadd16(ss); ss = xadd32(ss); }
                        if (fq == 0) part[((size_t)row * nh + (u.pn * 2 + bj)) * 4 + wc] = ss; } } }
    }
};
struct EpiResid {
    static constexpr bool PERM = false;
    float* X; int ldc;
    __device__ __forceinline__ void operator()(const f32x4 (&acc)[2][2][4][2], const Unit& u, int wr, int wc, int fr, int fq) const {
        const int row0 = u.pm * BM + wr * 64 + fr, col0 = u.pn * BM + wc * 32 + 4 * fq;
#pragma unroll
        for (int ai = 0; ai < 2; ++ai)
#pragma unroll
            for (int m = 0; m < 4; ++m) { float* rowp = X + (size_t)(row0 + ai * HALF + m * 16) * ldc + col0;
#pragma unroll
                for (int bj = 0; bj < 2; ++bj)
#pragma unroll
                    for (int n = 0; n < 2; ++n) { f32x4* q = (f32x4*)(rowp + bj * HALF + n * 16); *q = *q + acc[ai][bj][m][n]; }
                if (m == 3) asm volatile("" ::: "memory"); }
    }
};
struct EpiDelta {
    static constexpr bool PERM = true;
    bf16_t* O; int ldc; const bf16_t* X;
    static constexpr bool HAS_PRE = false;
    __device__ __forceinline__ void pre(const Unit&, int, int, f32x4 (&)[1]) const {}
    __device__ __forceinline__ void operator()(const f32x4 (&acc)[2][2][4][2], const Unit& u, int wr, int wc, int fr, int fq, const f32x4 (&)[1]) const {
        const int row0 = u.pm * BM + wr * 64 + fr, col0 = u.pn * BM + wc * 32 + 8 * fq;
        u32x4 xv[2][4][2];
#pragma unroll
        for (int ai = 0; ai < 2; ++ai)
#pragma unroll
            for (int m = 0; m < 4; ++m)
#pragma unroll
                for (int bj = 0; bj < 2; ++bj) xv[ai][m][bj] = *(const u32x4*)(X + (size_t)(row0 + ai * HALF + m * 16) * ldc + col0 + bj * HALF);
#pragma unroll
        for (int ai = 0; ai < 2; ++ai)
#pragma unroll
            for (int m = 0; m < 4; ++m) { bf16_t* rowp = O + (size_t)(row0 + ai * HALF + m * 16) * ldc + col0;
#pragma unroll
                for (int bj = 0; bj < 2; ++bj) { const f32x4 v0 = acc[ai][bj][m][0], v1 = acc[ai][bj][m][1]; const u32x4 x = xv[ai][m][bj];
                    u32x4 w; w.x = pk2(v0[0] + __uint_as_float(x.x << 16), v0[1] + __uint_as_float(x.x & 0xffff0000u)); w.y = pk2(v0[2] + __uint_as_float(x.y << 16), v0[3] + __uint_as_float(x.y & 0xffff0000u));
                    w.z = pk2(v1[0] + __uint_as_float(x.z << 16), v1[1] + __uint_as_float(x.z & 0xffff0000u)); w.w = pk2(v1[2] + __uint_as_float(x.w << 16), v1[3] + __uint_as_float(x.w & 0xffff0000u));
                    *(u32x4*)(rowp + bj * HALF) = w; } }
    }
};
struct EpiSwiglu {
    static constexpr bool PERM = true;
    bf16_t* O; const float* rss;
    static constexpr bool HAS_PRE = true;
    __device__ __forceinline__ void pre(const Unit& u, int wr, int fr, f32x4 (&pv)[1]) const {
        const int row0 = u.pm * BM + wr * 64 + fr;
#pragma unroll
        for (int q = 0; q < 4; ++q) pv[0][q] = rss[row0 + q * 16]; }
    __device__ __forceinline__ void operator()(const f32x4 (&acc)[2][2][4][2], const Unit& u, int wr, int wc, int fr, int fq, const f32x4 (&pv)[1]) const {
        const int row0 = u.pm * BM + wr * 64 + fr, col0 = (u.pn & 7) * 128 + wc * 32 + 8 * fq;
        f32x4 pw; pw[0] = rss[row0 + HALF]; pw[1] = rss[row0 + HALF + 16]; pw[2] = rss[row0 + HALF + 32]; pw[3] = rss[row0 + HALF + 48];
#pragma unroll
        for (int ai = 0; ai < 2; ++ai)
#pragma unroll
            for (int m = 0; m < 4; ++m) { const float rsc = ai ? pw[m] : pv[0][m];
                const f32x4 g0 = acc[ai][0][m][0] * rsc, g1 = acc[ai][0][m][1] * rsc, u0 = acc[ai][1][m][0] * rsc, u1 = acc[ai][1][m][1] * rsc;
                u32x4 w; w.x = pk2(silu_f(g0[0]) * u0[0], silu_f(g0[1]) * u0[1]); w.y = pk2(silu_f(g0[2]) * u0[2], silu_f(g0[3]) * u0[3]);
                w.z = pk2(silu_f(g1[0]) * u1[0], silu_f(g1[1]) * u1[1]); w.w = pk2(silu_f(g1[2]) * u1[2], silu_f(g1[3]) * u1[3]);
                *(u32x4*)(O + (size_t)(row0 + ai * HALF + m * 16) * FF + col0) = w; }
    }
};
struct EpiDown {
    static constexpr bool PERM = true;
    bf16_t* O; const float* gate;
    static constexpr bool HAS_PRE = true;
    __device__ __forceinline__ void pre(const Unit& u, int wr, int fr, f32x4 (&pv)[1]) const {
        const int row0 = u.pm * BM + wr * 64 + fr;
#pragma unroll
        for (int q = 0; q < 4; ++q) pv[0][q] = gate[row0 + q * 16]; }
    __device__ __forceinline__ void operator()(const f32x4 (&acc)[2][2][4][2], const Unit& u, int wr, int wc, int fr, int fq, const f32x4 (&pv)[1]) const {
        const int row0 = u.pm * BM + wr * 64 + fr, col0 = (u.pn & 7) * BM + wc * 32 + 8 * fq;
        f32x4 pw; pw[0] = gate[row0 + HALF]; pw[1] = gate[row0 + HALF + 16]; pw[2] = gate[row0 + HALF + 32]; pw[3] = gate[row0 + HALF + 48];
#pragma unroll
        for (int ai = 0; ai < 2; ++ai)
#pragma unroll
            for (int m = 0; m < 4; ++m) { const int row = row0 + ai * HALF + m * 16; const float gt = ai ? pw[m] : pv[0][m]; bf16_t* rowp = O + (size_t)row * DM + col0;
#pragma unroll
                for (int bj = 0; bj < 2; ++bj) { const f32x4 v0 = acc[ai][bj][m][0] * gt, v1 = acc[ai][bj][m][1] * gt;
                    u32x4 w; w.x = pk2(v0[0], v0[1]); w.y = pk2(v0[2], v0[3]); w.z = pk2(v1[0], v1[1]); w.w = pk2(v1[2], v1[3]);
                    *(u32x4*)(rowp + bj * HALF) = w; } }
    }
};

template <class Epi, class Sched, bool GATHER, int B_AUX = 0>
__device__ __forceinline__ void gemm_phase(LAS unsigned char* lds, const Gemm g, const Sched& S, const Epi& E) {
    int tid = threadIdx.x; asm volatile("" : "+v"(tid));
    const int wid = __builtin_amdgcn_readfirstlane(tid >> 6), lane = tid & 63, wr = wid >> 2, wc = wid & 3, fr = lane & 15, fq = lane >> 4;
    const int K = g.K, nt = K / BK;
    unsigned voffA[2], voffB[2];
#pragma unroll
    for (int i = 0; i < 2; ++i) { int R, C; stage_rc(tid * 16 + i * 8192, R, C); const int Rb = Epi::PERM ? ((R & ~31) + perm32(R & 31)) : R;
        voffA[i] = (unsigned)(R * K + C) * 2u; voffB[i] = (unsigned)(Rb * K + C) * 2u; }
    const size_t kstep = (size_t)(BK * 2);
    const size_t hstep = (size_t)HALF * K * 2;
    const size_t tstep = 2 * hstep;
    const unsigned ldsw = (unsigned)wid * 1024u;
    const int aoff = lds_byte(wr * 64 + fr, fq * 8), boff = lds_byte(wc * 32 + fr, fq * 8);
    unsigned gA[2][2];
#define PG8_SA(b, h) (((b) * 2 + (h)) * HTB)
#define PG8_SB(b, h) ((4 + (b) * 2 + (h)) * HTB)
#define PG8_STAGE(bufoff, gbase, voff) do { _Pragma("unroll") for (int _i = 0; _i < 2; ++_i) \
        __builtin_amdgcn_global_load_lds((const unsigned*)((const char*)(gbase) + (voff)[_i]), (LAS unsigned*)(lds + (bufoff) + ldsw + _i * 8192), 16, 0, 0); } while (0)
#define PG8_STAGEB(bufoff, gbase, voff) do { _Pragma("unroll") for (int _i = 0; _i < 2; ++_i) \
        __builtin_amdgcn_global_load_lds((const unsigned*)((const char*)(gbase) + (voff)[_i]), (LAS unsigned*)(lds + (bufoff) + ldsw + _i * 8192), 16, 0, B_AUX); } while (0)
#define PG8_ASTAGE(b, h, kp, NX) do { if constexpr (GATHER) { PG8_STAGE(PG8_SA(b, h), kp, gA[h]); } \
        else { PG8_STAGE(PG8_SA(b, h), (kp) + (h) * hstep, voffA); } } while (0)
#define PG8_ROWS(dst, un) do { _Pragma("unroll") for (int _i = 0; _i < 2; ++_i) { int _R, _C; stage_rc(tid * 16 + _i * 8192, _R, _C); _Pragma("unroll") for (int _h = 0; _h < 2; ++_h) \
        dst[_h][_i] = (unsigned)g.rowidx[(un).pm * BM + _h * HALF + _R] * (unsigned)(K * 2) + (unsigned)_C * 2u; } } while (0)
#define PG8_LDA(dst, b, h) do { _Pragma("unroll") for (int m = 0; m < 4; ++m) _Pragma("unroll") for (int k = 0; k < 2; ++k) dst[m][k] = *(const LAS bf16x8*)(lds + PG8_SA(b, h) + aoff + m * 2048 + k * 1024); } while (0)
#define PG8_LDB(dst, b, h) do { _Pragma("unroll") for (int n = 0; n < 2; ++n) _Pragma("unroll") for (int k = 0; k < 2; ++k) dst[n][k] = *(const LAS bf16x8*)(lds + PG8_SB(b, h) + boff + n * 2048 + k * 1024); } while (0)
#define PG8_MMA(ai, bj, At, Bt) do { __builtin_amdgcn_s_setprio(1); _Pragma("unroll") for (int m = 0; m < 4; ++m) _Pragma("unroll") for (int n = 0; n < 2; ++n) _Pragma("unroll") for (int k = 0; k < 2; ++k) \
        acc[ai][bj][m][n] = __builtin_amdgcn_mfma_f32_16x16x32_bf16(Bt[n][k], At[m][k], acc[ai][bj][m][n], 0, 0, 0); __builtin_amdgcn_s_setprio(0); } while (0)
#define PG8_WAIT_V(n) asm volatile("s_waitcnt vmcnt(" #n ")" ::: "memory")
#define PG8_WAIT_L(n) asm volatile("s_waitcnt lgkmcnt(" #n ")" ::: "memory")
#define PG8_BAR __builtin_amdgcn_s_barrier()
#define PG8_SCHED __builtin_amdgcn_sched_barrier(0)
    Unit cur, nxt; int ui = 0;
    if (!S.next(0, cur)) return;
    f32x4 acc[2][2][4][2];
#pragma unroll
    for (int a = 0; a < 2; ++a)
#pragma unroll
        for (int b = 0; b < 2; ++b)
#pragma unroll
            for (int m = 0; m < 4; ++m)
#pragma unroll
                for (int n = 0; n < 2; ++n) acc[a][b][m][n] = (f32x4){0.f, 0.f, 0.f, 0.f};
    bf16x8 At[4][2], B0[2][2], B1[2][2];
    f32x4 pv[1] = {(f32x4){1.f, 1.f, 1.f, 1.f}};
    const char* cA = GATHER ? (const char*)g.A : (const char*)g.A + (size_t)cur.pm * tstep; const char* cB = (const char*)g.Bt + (size_t)cur.pn * tstep;
    if constexpr (GATHER) { PG8_ROWS(gA, cur); }
    PG8_STAGEB(PG8_SB(0, 0), cB, voffB); PG8_STAGEB(PG8_SB(0, 1), cB + hstep, voffB); PG8_ASTAGE(0, 0, cA, false); PG8_ASTAGE(0, 1, cA, false);
    if (wr == 1) PG8_BAR;
    PG8_WAIT_V(2); PG8_BAR;
    PG8_STAGEB(PG8_SB(1, 0), cB + kstep, voffB); PG8_ASTAGE(1, 0, cA + kstep, false); PG8_STAGEB(PG8_SB(1, 1), cB + hstep + kstep, voffB);
    PG8_WAIT_V(6); PG8_BAR;
    for (;;) {
        const bool has_next = S.next(ui + 1, nxt);
        const char* nA = has_next ? (GATHER ? (const char*)g.A : (const char*)g.A + (size_t)nxt.pm * tstep) : cA; const char* nB = has_next ? (const char*)g.Bt + (size_t)nxt.pn * tstep : cB;
        for (int t = 0; t < nt; t += 2) {
            const bool last = (t == nt - 2);
            const char* a1 = cA + (size_t)(t + 1) * kstep;
            const char* a2 = last ? nA : cA + (size_t)(t + 2) * kstep; const char* b2 = last ? nB : cB + (size_t)(t + 2) * kstep;
            const char* a3 = a2 + kstep; const char* b3 = b2 + kstep;
            if constexpr (Epi::HAS_PRE) { if (last) E.pre(cur, wr, fr, pv); }
            PG8_LDB(B0, 0, 0); PG8_LDB(B1, 0, 1); PG8_SCHED; PG8_LDA(At, 0, 0); PG8_ASTAGE(1, 1, a1, false);
            if constexpr (GATHER) { if (last && has_next) { PG8_ROWS(gA, nxt); } }
            PG8_WAIT_V(8); PG8_WAIT_L(0); PG8_BAR; PG8_MMA(0, 0, At, B0); PG8_MMA(0, 1, At, B1); PG8_BAR; PG8_SCHED;
            PG8_LDA(At, 0, 1); PG8_STAGEB(PG8_SB(0, 0), b2, voffB); PG8_STAGEB(PG8_SB(0, 1), b2 + hstep, voffB); PG8_ASTAGE(0, 0, a2, last);
            PG8_WAIT_V(8); PG8_WAIT_L(0); PG8_BAR; PG8_MMA(1, 0, At, B0); PG8_MMA(1, 1, At, B1); PG8_BAR; PG8_SCHED;
            PG8_LDB(B0, 1, 0); PG8_LDB(B1, 1, 1); PG8_SCHED; PG8_LDA(At, 1, 0); PG8_ASTAGE(0, 1, a2, last);
            PG8_WAIT_V(8); PG8_WAIT_L(0); PG8_BAR; PG8_MMA(0, 0, At, B0); PG8_MMA(0, 1, At, B1); PG8_BAR; PG8_SCHED;
            PG8_LDA(At, 1, 1); PG8_STAGEB(PG8_SB(1, 0), b3, voffB); PG8_STAGEB(PG8_SB(1, 1), b3 + hstep, voffB); PG8_ASTAGE(1, 0, a3, last);
            PG8_WAIT_V(8); PG8_WAIT_L(0); PG8_BAR; PG8_MMA(1, 0, At, B0); PG8_MMA(1, 1, At, B1); PG8_BAR; PG8_SCHED;
        }
        if (wr == 0) PG8_BAR;
        E(acc, cur, wr, wc, fr, fq, pv);
        if (DUP_ON(21)) { asm volatile("" ::: "memory"); E(acc, cur, wr, wc, fr, fq, pv); }
        if (!has_next) break;
#pragma unroll
        for (int a = 0; a < 2; ++a)
#pragma unroll
            for (int b = 0; b < 2; ++b)
#pragma unroll
                for (int m = 0; m < 4; ++m)
#pragma unroll
                    for (int n = 0; n < 2; ++n) acc[a][b][m][n] = (f32x4){0.f, 0.f, 0.f, 0.f};
        cur = nxt; cA = nA; cB = nB; ++ui;
        if (wr == 1) PG8_BAR;
    }
    PG8_WAIT_V(0);
    PG8_BAR;
#undef PG8_SA
#undef PG8_SB
#undef PG8_STAGE
#undef PG8_ASTAGE
#undef PG8_STAGEB
#undef PG8_ROWS
#undef PG8_LDA
#undef PG8_LDB
#undef PG8_MMA
#undef PG8_WAIT_V
#undef PG8_WAIT_L
#undef PG8_BAR
#undef PG8_SCHED
}
}

#define XB_TMO      128
#define XB_XCNT(j)  (256  + 64 * (j))
#define XB_XSUB(j)  (1280 + 64 * (j))
#define XB_XGEN(j)  (2304 + 64 * (j))
#define XB_TOP      3328
#define XB_TOPGEN   3392
#define XCD_BAR_WORDS 3456
#define XB_SPIN_CAP (1u << 18)
__device__ __forceinline__ unsigned xb_ld(unsigned* p)              { return __hip_atomic_load(p, __ATOMIC_RELAXED, __HIP_MEMORY_SCOPE_AGENT); }
__device__ __forceinline__ unsigned xb_add(unsigned* p, unsigned v) { return __hip_atomic_fetch_add(p, v, __ATOMIC_RELAXED, __HIP_MEMORY_SCOPE_AGENT); }
__device__ __forceinline__ unsigned xb_xcc_id() { return (unsigned)__builtin_amdgcn_s_getreg((3 << 11) | 20) & 0xFu; }
#define XB_SPIN(cond, bar) do { unsigned _sp = 0; while (cond) { \
    if ((++_sp & 255u) == 0u) { if (xb_ld(&(bar)[XB_TMO])) break; if (_sp > XB_SPIN_CAP) { atomicAdd(&(bar)[XB_TMO], 1u); break; } } } } while (0)
struct XcdBarrier { unsigned* bar; unsigned x; volatile LAS unsigned* st; };
__device__ __forceinline__ XcdBarrier xcd_barrier_post(unsigned* bar, volatile LAS unsigned* st) {
    XcdBarrier b; b.bar = bar; b.x = xb_xcc_id(); b.st = st;
    if (threadIdx.x == 0) (void)xb_add(&bar[XB_XCNT(b.x)], 1u);
    return b;
}
__device__ __forceinline__ void xcd_barrier_complete(unsigned* bar, unsigned x, unsigned& nloc, unsigned& nx) {
    const unsigned G = gridDim.x * gridDim.y * gridDim.z;
    unsigned sum, cnt, mine, sp = 0u;
    for (;;) {
        sum = 0u; cnt = 0u; mine = 0u;
#pragma unroll
        for (unsigned j = 0; j < 16; ++j) { const unsigned c = xb_ld(&bar[XB_XCNT(j)]); sum += c; cnt += (c > 0u) ? 1u : 0u; mine = (j == x) ? c : mine; }
        if (sum == G) break;
        __builtin_amdgcn_s_sleep(1);
        if ((++sp & 255u) == 0u) { if (xb_ld(&bar[XB_TMO])) break; if (sp > XB_SPIN_CAP) { atomicAdd(&bar[XB_TMO], 1u); break; } }
    }
    nloc = mine > 0u ? mine : 1u; nx = cnt > 0u ? cnt : 1u;
}
__device__ __noinline__ void xcd_barrier_impl(unsigned* bar_, unsigned x_, volatile LAS unsigned* st_) {
    XcdBarrier b; b.bar = bar_; b.x = x_; b.st = st_;
    asm volatile("s_waitcnt vmcnt(0)" ::: "memory");
    __syncthreads();
    if (threadIdx.x == 0) {
        unsigned* bar = b.bar;
        __builtin_amdgcn_s_waitcnt(0);
        unsigned nloc = b.st[0], nx = b.st[1];
        if (nloc == 0u) { xcd_barrier_complete(bar, b.x, nloc, nx); b.st[0] = nloc; b.st[1] = nx; }
        const unsigned old = xb_add(&bar[XB_XSUB(b.x)], 1u);
        const unsigned gen = old / nloc;
        if (old + 1u == (gen + 1u) * nloc) {
            __builtin_amdgcn_fence(__ATOMIC_RELEASE, "agent");
            asm volatile("s_waitcnt vmcnt(0)" ::: "memory");
            const unsigned og = xb_add(&bar[XB_TOP], 1u);
            const unsigned tg = og / nx;
            if (og + 1u == (tg + 1u) * nx) xb_add(&bar[XB_TOPGEN], 1u);
            else XB_SPIN(xb_ld(&bar[XB_TOPGEN]) == tg, bar);
            __builtin_amdgcn_fence(__ATOMIC_ACQUIRE, "agent");
            xb_add(&bar[XB_XGEN(b.x)], 1u);
            asm volatile("s_waitcnt vmcnt(0)" ::: "memory");
        } else {
            XB_SPIN(xb_ld(&bar[XB_XGEN(b.x)]) == gen, bar);
            __builtin_amdgcn_fence(__ATOMIC_ACQUIRE, "agent");
            asm volatile("s_waitcnt vmcnt(0)" ::: "memory");
        }
    }
    __syncthreads();
}

__device__ __forceinline__ void xcd_barrier(const XcdBarrier& b) { xcd_barrier_impl(b.bar, b.x, b.st); }

struct Params { const float* in[21]; float* out; unsigned char* ws; int lo, hi, li, pad; };
enum { I_X = 0, I_MEM, I_N1G, I_WINA, I_AQG, I_AKG, I_SINK, I_WINR, I_RDF, I_RDB, I_ROG, I_MNG, I_WMKV, I_CQG, I_CKG, I_WOUT, I_N2G, I_WR, I_WG, I_WU, I_WD };

template <bool NTS = true>
__device__ __forceinline__ void transpose_item(const float* src, int N, int K, bf16_t* dst, int drow0, int k0, int n0, LAS unsigned* scr, int lane, const float* kgain = nullptr) {
    f32x4 v[16];
    const int c4 = (lane & 15) * 4, kr = lane >> 4;
#pragma unroll
    for (int j = 0; j < 16; ++j) v[j] = __builtin_nontemporal_load((const f32x4*)(src + (size_t)(k0 + 4 * j + kr) * N + n0 + c4));
#pragma unroll
    for (int j = 0; j < 16; ++j) { const int k = 4 * j + kr; const float gk = kgain ? kgain[k0 + k] : 1.0f;
        scr[k * 33 + (lane & 15) * 2] = pk2(v[j][0] * gk, v[j][1] * gk); scr[k * 33 + (lane & 15) * 2 + 1] = pk2(v[j][2] * gk, v[j][3] * gk); }
    asm volatile("s_waitcnt lgkmcnt(0)" ::: "memory");
    const LAS unsigned short* sh = (const LAS unsigned short*)scr;
    const int kc = lane & 7;
#pragma unroll
    for (int jj = 0; jj < 8; ++jj) { const int n = (lane >> 3) + 8 * jj;
        unsigned h[8];
#pragma unroll
        for (int e = 0; e < 8; ++e) h[e] = sh[(8 * kc + e) * 66 + n];
        u32x4 w; w.x = h[0] | (h[1] << 16); w.y = h[2] | (h[3] << 16); w.z = h[4] | (h[5] << 16); w.w = h[6] | (h[7] << 16);
        if constexpr (NTS) __builtin_nontemporal_store(w, (u32x4*)(dst + (size_t)(drow0 + n) * K + k0 + 8 * kc)); else *(u32x4*)(dst + (size_t)(drow0 + n) * K + k0 + 8 * kc) = w; }
    asm volatile("s_waitcnt lgkmcnt(0)" ::: "memory");
}
__device__ __forceinline__ void phase_convert(const Params& p, bool moe_too, int part, LAS unsigned char* lds, int gw, int ngw, int wave, int lane) {
    LAS unsigned* scr = (LAS unsigned*)(lds + wave * 8448);
    unsigned char* ws = p.ws;
    constexpr int C0 = 2 * 1536, C1 = C0 + 2 * 2560, C2 = C1 + 4 * 512, C3 = C2 + 4 * 1024, C4 = C3 + 64 * 512, C5 = C4 + 64 * 512, C6 = C5 + 64 * 512;
    const int nj = part == 0 ? (moe_too ? C6 : C3) : (part == 1 ? 1536 + 2048 : C3 - 1536 - 2048);
    for (int j = gw; j < nj; j += ngw) {
        const int it = part == 0 ? j : (part == 1 ? (j < 1536 ? j : C1 + (j - 1536)) : (j < C1 - 1536 ? 1536 + j : C2 + (j - (C1 - 1536))));
        if (it < C0) { const int mat = it / 1536, r = it % 1536, kb = r / 48, nb = r % 48;
            transpose_item(p.in[I_WINA] + (size_t)mat * DM * ATT_W, ATT_W, DM, (bf16_t*)(ws + WS_WINA) + (size_t)mat * ATT_W * DM, 64 * nb, 64 * kb, 64 * nb, scr, lane, p.in[I_N1G] + (size_t)(2 * mat) * DM); }
        else if (it < C1) { const int q = it - C0, mat = q / 2560, r = q % 2560, kb = r / 80, nb = r % 80;
            transpose_item(p.in[I_WINR] + (size_t)mat * DM * RET_W, RET_W, DM, (bf16_t*)(ws + WS_WINR) + (size_t)mat * RET_W * DM, 64 * nb, 64 * kb, 64 * nb, scr, lane, p.in[I_N1G] + (size_t)(2 * mat + 1) * DM); }
        else if (it < C2) { const int q = it - C1, mat = q / 512, r = q % 512, kb = r / 16, nb = r % 16;
            transpose_item(p.in[I_WMKV] + (size_t)mat * DM * 1024, 1024, DM, (bf16_t*)(ws + WS_WMKV) + (size_t)mat * 1024 * DM, 64 * nb, 64 * kb, 64 * nb, scr, lane); }
        else if (it < C3) { const int q = it - C2, mat = q / 1024, r = q % 1024, kb = r / 32, nb = r % 32;
            transpose_item(p.in[I_WOUT] + (size_t)mat * DM * DM, DM, DM, (bf16_t*)(ws + WS_WOUT) + (size_t)mat * DM * DM, 64 * nb, 64 * kb, 64 * nb, scr, lane); }
        else if (it < C5) { const int up = it >= C4; const int q = it - (up ? C4 : C3), mat = q / 512, r = q % 512, kb = r / 16, nb = r % 16;
            const int n0 = 64 * nb, drow0 = 256 * (n0 >> 7) + 128 * up + (n0 & 127);
            transpose_item(p.in[up ? I_WU : I_WG] + (size_t)mat * DM * FF, FF, DM, (bf16_t*)(ws + WS_WGU) + (size_t)mat * 2048 * DM, drow0, 64 * kb, n0, scr, lane, p.in[I_N2G] + (size_t)(mat >> 4) * DM); }
        else { const int q = it - C5, mat = q / 512, r = q % 512, kb = r / 32, nb = r % 32;
            transpose_item(p.in[I_WD] + (size_t)mat * FF * DM, DM, FF, (bf16_t*)(ws + WS_WDN) + (size_t)mat * DM * FF, 64 * nb, 64 * kb, 64 * nb, scr, lane); }
    }
    bf16_t* memn = (bf16_t*)(ws + WS_MEMN);
    for (int r = gw; r < (part == 2 ? 0 : 4 * 512); r += ngw) { const int l = r >> 9, m = r & 511;
        const float* xr = p.in[I_MEM] + (size_t)m * DM; const float* gn = p.in[I_MNG] + l * DM;
        f32x4 v[8]; float ss = 0.f;
#pragma unroll
        for (int j = 0; j < 8; ++j) { v[j] = *(const f32x4*)(xr + 256 * j + 4 * lane); ss += (v[j][0] * v[j][0] + v[j][1] * v[j][1]) + (v[j][2] * v[j][2] + v[j][3] * v[j][3]); }
        const float rs = 1.0f / sqrtf(wave_sum(ss, lane) * (1.0f / DM) + EPS);
#pragma unroll
        for (int j = 0; j < 8; ++j) { const f32x4 gg = *(const f32x4*)(gn + 256 * j + 4 * lane); u32x2 w; w.x = pk2(v[j][0] * rs * gg[0], v[j][1] * rs * gg[1]); w.y = pk2(v[j][2] * rs * gg[2], v[j][3] * rs * gg[3]);
            *(u32x2*)(memn + (size_t)r * DM + 256 * j + 4 * lane) = w; }
    }
}

__device__ __forceinline__ void convert_moe_layer(const Params& p, int L, int i0, int i1, int w, int nw, LAS unsigned char* lds, int wave, int lane) {
    LAS unsigned* scr = (LAS unsigned*)(lds + wave * 8448);
    unsigned char* ws = p.ws;
    for (int ii = i0 + w; ii < i1; ii += nw) {
        const int i = ii < 8192 ? 16384 + ii : ii - 8192;
        if (i < 16384) { const int up = i >= 8192; const int q = i - up * 8192, mat = L * NEXP + q / 512, r = q % 512, kb = r / 16, nb = r % 16;
            const int n0 = 64 * nb, drow0 = 256 * (n0 >> 7) + 128 * up + (n0 & 127);
            transpose_item<false>(p.in[up ? I_WU : I_WG] + (size_t)mat * DM * FF, FF, DM, (bf16_t*)(ws + WS_WGU) + (size_t)mat * 2048 * DM, drow0, 64 * kb, n0, scr, lane, p.in[I_N2G] + (size_t)L * DM); }
        else { const int q = i - 16384, mat = L * NEXP + q / 512, r = q % 512, kb = r / 32, nb = r % 32;
            transpose_item(p.in[I_WD] + (size_t)mat * FF * DM, DM, FF, (bf16_t*)(ws + WS_WDN) + (size_t)mat * DM * FF, 64 * nb, 64 * kb, 64 * nb, scr, lane); }
    }
}

__device__ __forceinline__ void addrow_bf16(f32x4 (&v)[8], const u32x2 (&w)[8]) {
#pragma unroll
    for (int j = 0; j < 8; ++j) { v[j][0] += __uint_as_float(w[j].x << 16); v[j][1] += __uint_as_float(w[j].x & 0xffff0000u); v[j][2] += __uint_as_float(w[j].y << 16); v[j][3] += __uint_as_float(w[j].y & 0xffff0000u); }
}
__device__ __forceinline__ void combine_row(f32x4 (&v)[8], int iv, int b, const bf16_t* Y, int lane) {
    unsigned mask = (unsigned)__builtin_amdgcn_readfirstlane((int)(__ballot(iv >= 0) & 0xffffull));
    while (mask) {
        const int e0 = __builtin_ctz(mask); mask &= mask - 1u;
        const int c0 = __builtin_amdgcn_readlane(iv, e0);
        const bool two = mask != 0u;
        const int e1 = two ? __builtin_ctz(mask) : e0; if (two) mask &= mask - 1u;
        const int c1 = __builtin_amdgcn_readlane(iv, e1);
        const bf16_t* y0 = Y + (size_t)((b * NEXP + e0) * CAP + c0) * DM + 4 * lane;
        const bf16_t* y1 = Y + (size_t)((b * NEXP + e1) * CAP + c1) * DM + 4 * lane;
        u32x2 w0[8], w1[8];
#pragma unroll
        for (int j = 0; j < 8; ++j) { w0[j] = __builtin_nontemporal_load((const u32x2*)(y0 + 256 * j)); w1[j] = __builtin_nontemporal_load((const u32x2*)(y1 + 256 * j)); }
        addrow_bf16(v, w0);
        if (two) addrow_bf16(v, w1);
    }
}
__device__ __forceinline__ void xrow_finish(const f32x4 (&v)[8], int t, bool fin, float* outp, bf16_t* XB, float* rs1, int lane) {
    if (fin) {
#pragma unroll
        for (int j = 0; j < 8; ++j) __builtin_nontemporal_store(v[j], (f32x4*)(outp + (size_t)t * DM + 256 * j + 4 * lane));
    } else {
        float ss = 0.f;
#pragma unroll
        for (int j = 0; j < 8; ++j) { ss += (v[j][0] * v[j][0] + v[j][1] * v[j][1]) + (v[j][2] * v[j][2] + v[j][3] * v[j][3]);
            u32x2 w; w.x = pk2(v[j][0], v[j][1]); w.y = pk2(v[j][2], v[j][3]); *(u32x2*)(XB + (size_t)t * DM + 256 * j + 4 * lane) = w; }
        const float rs = 1.0f / sqrtf(wave_sum(ss, lane) * (1.0f / DM) + EPS);
        if (lane == 0) rs1[t] = rs;
    }
}
__device__ __forceinline__ void phase_norm1(const Params& p, int L, bool combine, bool do_norm, int gw, int ngw, int lane) {
    const int* inv = (const int*)(p.ws + WS_INV);
    const bf16_t* Y = (const bf16_t*)(p.ws + WS_Y); const bf16_t* XR = (const bf16_t*)(p.ws + WS_XR);
    bf16_t* XB = (bf16_t*)(p.ws + WS_H); float* rs1 = (float*)(p.ws + WS_RS1);
    for (int t = gw; t < TT; t += 2 * ngw) {
        const int t1 = t + ngw; const bool has1 = t1 < TT; const int t1c = has1 ? t1 : t;
        f32x4 v0[8], v1[8];
        if (!combine) {
#pragma unroll
            for (int j = 0; j < 8; ++j) { v0[j] = *(const f32x4*)(p.in[I_X] + (size_t)t * DM + 256 * j + 4 * lane); v1[j] = *(const f32x4*)(p.in[I_X] + (size_t)t1c * DM + 256 * j + 4 * lane); }
        } else {
            const int iv0 = inv[(size_t)t * 16 + (lane & 15)], iv1 = inv[(size_t)t1c * 16 + (lane & 15)];
            { u32x2 d0[8], d1[8];
#pragma unroll
              for (int j = 0; j < 8; ++j) { d0[j] = __builtin_nontemporal_load((const u32x2*)(XR + (size_t)t * DM + 256 * j + 4 * lane)); d1[j] = __builtin_nontemporal_load((const u32x2*)(XR + (size_t)t1c * DM + 256 * j + 4 * lane)); }
#pragma unroll
              for (int j = 0; j < 8; ++j) { v0[j] = (f32x4){0.f, 0.f, 0.f, 0.f}; v1[j] = (f32x4){0.f, 0.f, 0.f, 0.f}; }
              addrow_bf16(v0, d0); addrow_bf16(v1, d1); }
            combine_row(v0, iv0, t >> 13, Y, lane);
            combine_row(v1, iv1, t1c >> 13, Y, lane);
        }
        xrow_finish(v0, t, !do_norm, p.out, XB, rs1, lane);
        if (has1) xrow_finish(v1, t1, !do_norm, p.out, XB, rs1, lane);
    }
}

constexpr int RW_STRIDE = 4112, RW_LO = 16 * RW_STRIDE, RW_XCH = 2 * 16 * RW_STRIDE;
__device__ __forceinline__ void phase_router(const Params& p, int L, LAS unsigned char* lds, int gw, int ngw, int tid, int lane) {
    const int wave = __builtin_amdgcn_readfirstlane(tid >> 6);
    const float* wr = p.in[I_WR] + (size_t)L * DM * NEXP; const float* gn = p.in[I_N2G] + (size_t)L * DM;
    const bf16_t* XR = (const bf16_t*)(p.ws + WS_XR); float* rs2 = (float*)(p.ws + WS_RS2);
    float* aff = (float*)(p.ws + WS_AFF);
    const int i16 = lane & 15, g4 = lane >> 4, half = wave >> 2;
    LAS float* xch = (LAS float*)(lds + RW_XCH) + ((wave & 3) * 64 + lane) * 5;
    u32x4 xa[16];
#define RT_LOAD(dst, T0_, c0) do { int T_ = (T0_) + (wave & 3); T_ = T_ < TT / 16 ? T_ : TT / 16 - 1; const size_t ro_ = (size_t)(16 * T_ + i16) * DM + 1024 * half + 8 * g4; \
        _Pragma("unroll") for (int i = 0; i < 16; ++i) dst[i] = *(const u32x4*)(XR + ro_ + 32 * ((c0) + i)); } while (0)
#define RT_STEP(src, c0) do { _Pragma("unroll") for (int i = 0; i < 16; ++i) { float v[8]; \
            v[0] = __uint_as_float(src[i].x << 16); v[1] = __uint_as_float(src[i].x & 0xffff0000u); v[2] = __uint_as_float(src[i].y << 16); v[3] = __uint_as_float(src[i].y & 0xffff0000u); \
            v[4] = __uint_as_float(src[i].z << 16); v[5] = __uint_as_float(src[i].z & 0xffff0000u); v[6] = __uint_as_float(src[i].w << 16); v[7] = __uint_as_float(src[i].w & 0xffff0000u); \
            ss += ((v[0] * v[0] + v[1] * v[1]) + (v[2] * v[2] + v[3] * v[3])) + ((v[4] * v[4] + v[5] * v[5]) + (v[6] * v[6] + v[7] * v[7])); \
            const bf16x8 bh = *(const LAS bf16x8*)(wb + 64 * ((c0) + i)), bl = *(const LAS bf16x8*)(wb + RW_LO + 64 * ((c0) + i)); \
            acc = mfma16(u4_to_bf8(src[i]), bh, acc); acc = mfma16(u4_to_bf8(src[i]), bl, acc); } } while (0)
    int T0 = bidx() * 4;
    if (T0 < TT / 16) RT_LOAD(xa, T0, 0);
    for (int c = tid; c < DM; c += 512) { const float g = gn[c];
#pragma unroll
        for (int q = 0; q < 4; ++q) { const f32x4 w = *(const f32x4*)(wr + (size_t)c * 16 + 4 * q);
#pragma unroll
            for (int i = 0; i < 4; ++i) { const float val = w[i] * g; const unsigned hi = pk2(val, 0.f) & 0xffffu; const unsigned lo = pk2(val - __uint_as_float(hi << 16), 0.f) & 0xffffu;
                *(LAS unsigned short*)(lds + (4 * q + i) * RW_STRIDE + 2 * c) = (unsigned short)hi; *(LAS unsigned short*)(lds + RW_LO + (4 * q + i) * RW_STRIDE + 2 * c) = (unsigned short)lo; } }
    }
    __syncthreads();
    for (; T0 < TT / 16; T0 += (int)gridDim.x * 4) {
        int T = T0 + (wave & 3); const bool tile_ok = T < TT / 16; T = tile_ok ? T : TT / 16 - 1;
        const LAS unsigned char* wb = lds + i16 * RW_STRIDE + (1024 * half + 8 * g4) * 2;
        f32x4 acc = (f32x4){0.f, 0.f, 0.f, 0.f}; float ss = 0.f;
        { u32x4 xb[16];
          RT_LOAD(xb, T0, 16);
          RT_STEP(xa, 0);
          if (T0 + (int)gridDim.x * 4 < TT / 16) RT_LOAD(xa, T0 + (int)gridDim.x * 4, 0);
          RT_STEP(xb, 16); }
        ss = xadd16(ss); ss = xadd32(ss);
        if (half == 1) { xch[0] = acc[0]; xch[1] = acc[1]; xch[2] = acc[2]; xch[3] = acc[3]; xch[4] = ss; }
        __syncthreads();
        if (half == 0) {
            acc[0] += xch[0]; acc[1] += xch[1]; acc[2] += xch[2]; acc[3] += xch[3]; ss += xch[4];
            const float rs = 1.0f / sqrtf(ss * (1.0f / DM) + EPS);
            if (tile_ok && g4 == 0) __hip_atomic_store(rs2 + 16 * T + i16, rs, __ATOMIC_RELAXED, __HIP_MEMORY_SCOPE_AGENT);
#pragma unroll
            for (int r = 0; r < 4; ++r) {
                const float rst = __int_as_float(__builtin_amdgcn_ds_bpermute((4 * g4 + r) << 2, __float_as_int(rs)));
                const float lg = acc[r] * rst;
                float mx = lg; mx = fmaxf(mx, SHX(mx, 1)); mx = fmaxf(mx, SHX(mx, 2)); mx = fmaxf(mx, SHX(mx, 4)); mx = fmaxf(mx, SHX(mx, 8));
                const float pe = expf(lg - mx);
                float sm = pe; sm += SHX(sm, 1); sm += SHX(sm, 2); sm += SHX(sm, 4); sm += SHX(sm, 8);
                const int t = 16 * T + 4 * g4 + r;
                if (tile_ok) __hip_atomic_store(aff + ((size_t)((t >> 13) * NEXP + i16)) * SEQ + (t & (SEQ - 1)), pe / sm, __ATOMIC_RELAXED, __HIP_MEMORY_SCOPE_AGENT);
            }
        }
        __syncthreads();
    }
    __syncthreads();
}

__device__ __forceinline__ void router_publish(unsigned* cnt) {
    asm volatile("s_waitcnt vmcnt(0)" ::: "memory");
    __syncthreads();
    if (threadIdx.x == 0) __hip_atomic_fetch_add(cnt, 1u, __ATOMIC_RELAXED, __HIP_MEMORY_SCOPE_AGENT);
}
__device__ __forceinline__ void router_wait(unsigned* cnt, unsigned need, unsigned* tmo) {
    if (threadIdx.x < 64) {
        unsigned sp = 0;
        while ((unsigned)__builtin_amdgcn_readfirstlane((int)__hip_atomic_load(cnt, __ATOMIC_RELAXED, __HIP_MEMORY_SCOPE_AGENT)) < need) {
            __builtin_amdgcn_s_sleep(2);
            if ((++sp & 255u) == 0u) { if (__hip_atomic_load(tmo, __ATOMIC_RELAXED, __HIP_MEMORY_SCOPE_AGENT)) break; if (sp > (1u << 18)) { if (threadIdx.x == 0) atomicAdd(tmo, 1u); break; } } }
        __builtin_amdgcn_fence(__ATOMIC_ACQUIRE, "agent");
        asm volatile("s_waitcnt vmcnt(0)" ::: "memory");
    }
    __syncthreads();
}

__device__ __forceinline__ void phase_topk(const Params& p, LAS unsigned char* lds, int tid, int lane, int wave) {
    LAS unsigned* hist = (LAS unsigned*)lds;
    LAS unsigned* shw = (LAS unsigned*)(lds + 1024);
    const float* aff = (const float*)(p.ws + WS_AFF);
    int* rowidx = (int*)(p.ws + WS_ROWIDX); float* gatev = (float*)(p.ws + WS_GATEV); int* inv = (int*)(p.ws + WS_INV);
    const float* rs2 = (const float*)(p.ws + WS_RS2); float* rslot = (float*)(p.ws + WS_RSLOT);
    for (int u = bidx(); u < NB * NEXP; u += gridDim.x) {
        const int b = u >> 4, e = u & 15;
        unsigned key[16];
#pragma unroll
        for (int q = 0; q < 4; ++q) { const u32x4 w = *(const u32x4*)(aff + (size_t)u * SEQ + 16 * tid + 4 * q); key[4 * q] = w.x; key[4 * q + 1] = w.y; key[4 * q + 2] = w.z; key[4 * q + 3] = w.w; }
        unsigned prefix = 0u, mask = 0u, kk = CAP;
#pragma unroll 1
        for (int pass = 0; pass < 4; ++pass) {
            const int shift = 24 - 8 * pass;
            if (tid < 256) hist[tid] = 0u;
            __syncthreads();
#pragma unroll
            for (int i = 0; i < 16; ++i) if ((key[i] & mask) == prefix) __hip_atomic_fetch_add(&hist[(key[i] >> shift) & 255u], 1u, __ATOMIC_RELAXED, __HIP_MEMORY_SCOPE_WORKGROUP);
            __syncthreads();
            if (wave == 0) {
                const unsigned c0 = hist[255 - 4 * lane], c1 = hist[254 - 4 * lane], c2 = hist[253 - 4 * lane], c3 = hist[252 - 4 * lane];
                const unsigned tot = c0 + c1 + c2 + c3; unsigned incl = tot;
#pragma unroll
                for (int o = 1; o < 64; o <<= 1) { const unsigned y = shup_u(incl, o, lane); if (lane >= o) incl += y; }
                const unsigned excl = incl - tot;
                if (excl < kk && kk <= incl) { unsigned rem = kk - excl, bin;
                    if (rem <= c0) bin = 255 - 4 * lane; else { rem -= c0; if (rem <= c1) bin = 254 - 4 * lane; else { rem -= c1; if (rem <= c2) bin = 253 - 4 * lane; else { rem -= c2; bin = 252 - 4 * lane; } } }
                    shw[0] = bin; shw[1] = rem; }
            }
            __syncthreads();
            prefix |= shw[0] << shift; mask |= 255u << shift; kk = shw[1];
        }
        unsigned ne = 0;
#pragma unroll
        for (int i = 0; i < 16; ++i) ne += (key[i] == prefix) ? 1u : 0u;
        unsigned incl = ne;
#pragma unroll
        for (int o = 1; o < 64; o <<= 1) { const unsigned y = shup_u(incl, o, lane); if (lane >= o) incl += y; }
        if (lane == 63) shw[8 + wave] = incl;
        __syncthreads();
        unsigned eqbase = incl - ne;
#pragma unroll
        for (int w = 0; w < 8; ++w) eqbase += (w < wave) ? shw[8 + w] : 0u;
        unsigned selm = 0u, ns = 0u, er = eqbase;
#pragma unroll
        for (int i = 0; i < 16; ++i) { const bool gt = key[i] > prefix, eq = key[i] == prefix; const bool sel = gt || (eq && er < kk); er += eq ? 1u : 0u; selm |= sel ? (1u << i) : 0u; ns += sel ? 1u : 0u; }
        unsigned incl2 = ns;
#pragma unroll
        for (int o = 1; o < 64; o <<= 1) { const unsigned y = shup_u(incl2, o, lane); if (lane >= o) incl2 += y; }
        if (lane == 63) shw[16 + wave] = incl2;
        __syncthreads();
        unsigned cpos = incl2 - ns;
#pragma unroll
        for (int w = 0; w < 8; ++w) cpos += (w < wave) ? shw[16 + w] : 0u;
#pragma unroll
        for (int i = 0; i < 16; ++i) { const int tok = 16 * tid + i; const bool sel = (selm >> i) & 1u;
            if (sel) { rowidx[u * CAP + cpos] = b * SEQ + tok; gatev[u * CAP + cpos] = __uint_as_float(key[i]); rslot[u * CAP + cpos] = rs2[b * SEQ + tok]; }
            inv[((size_t)(b * SEQ + tok)) * 16 + e] = sel ? (int)cpos : -1;
            cpos += sel ? 1u : 0u; }
        __syncthreads();
    }
}

constexpr int AT_KS = 272, AT_VS = 288, AT_VOFF = 128 * AT_KS, AT_BUF = AT_VOFF + 128 * AT_VS;
__device__ __forceinline__ int xcd_vcu() { const int G = (int)gridDim.x, c = bidx(); return (G % 8 == 0) ? (c % 8) * (G / 8) + c / 8 : c; }
__device__ __forceinline__ float alibi_slope(int h) { return (h < 8) ? exp2f(-(float)(h + 1)) : exp2f(-0.5f * (float)(2 * (h - 8) + 1)); }
struct AttnU { int qrow0, krow_base, jb_lo, jb_hi, nq, qcol, kcol, vcol, ocol; float nslope2, m0; };
template <int MODE>
__device__ __forceinline__ void phase_attn_mode(const Params& p, int L, LAS unsigned char* lds, int tid, int lane, int wave) {
    const int li = L >> 1; const bool ret = (L & 1) != 0;
    const bf16_t* proj = (const bf16_t*)(p.ws + WS_PROJ); const int ldq = ret ? RET_W : ATT_W; const int qnh = ldq >> 7;
    const float* qpart = (const float*)(p.ws + WS_PART);
    const bf16_t* kvsrc = MODE == 0 ? proj : (const bf16_t*)(p.ws + WS_KVM); const int ldkv = MODE == 0 ? ldq : 4096;
    const float* kpart = MODE == 0 ? qpart : (const float*)(p.ws + WS_PARTM); const int knh = MODE == 0 ? qnh : 32;
    const float* qgain = MODE == 0 ? p.in[I_AQG] + li * 128 : p.in[I_CQG] + L * 128;
    const float* kgain = MODE == 0 ? p.in[I_AKG] + li * 128 : p.in[I_CKG] + L * 128;
    bf16_t* cat = (bf16_t*)(p.ws + WS_CAT);
    const int NU = MODE == 0 ? 1536 : 512, G = gridDim.x;
    const int i16 = lane & 15, g4 = lane >> 4;
    auto decode = [&](int u, AttnU& a) {
        if (MODE == 0) { const int hq = u % 12, n = (u / 12) & 63, b = u / 768, hk = hq / 3;
            a.qrow0 = b * SEQ + n * 128; a.krow_base = b * SEQ; a.jb_lo = n > 0 ? n - 1 : 0; a.jb_hi = n < 63 ? n + 1 : 63; a.nq = n;
            a.qcol = hq * 128; a.kcol = 1536 + hk * 128; a.vcol = 2048 + hk * 128; a.ocol = hq * 128;
            a.nslope2 = -alibi_slope(hq) * LOG2E; a.m0 = p.in[I_SINK][li * 12 + hq] * LOG2E; }
        else { const int hd = u & 3, n = (u >> 2) & 63, b = u >> 8;
            a.qrow0 = b * SEQ + n * 128; a.krow_base = L * 512 + b * MEML; a.jb_lo = 0; a.jb_hi = 1; a.nq = n;
            a.qcol = (ret ? 4608 : 2560) + hd * 128; a.kcol = L * 1024 + hd * 128; a.vcol = L * 1024 + 512 + hd * 128; a.ocol = 1536 + hd * 128;
            a.nslope2 = 0.f; a.m0 = -1e30f; }
    };
    u32x4 kraw[4], vraw[4]; f32x4 kpp[4];
    const unsigned lrow = (unsigned)(tid >> 4), lch = (unsigned)(tid & 15);
#define AT_PREFETCH(A, JB) do { const size_t kr0_ = (size_t)((A).krow_base + (JB) * 128); \
        _Pragma("unroll") for (int c = 0; c < 4; ++c) { const size_t kr_ = kr0_ + lrow + 32 * c; \
            kraw[c] = *(const u32x4*)(kvsrc + kr_ * ldkv + (A).kcol + 8 * lch); vraw[c] = *(const u32x4*)(kvsrc + kr_ * ldkv + (A).vcol + 8 * lch); \
            kpp[c] = *(const f32x4*)(kpart + (kr_ * knh + ((A).kcol >> 7)) * 4); } } while (0)
    int u = xcd_vcu(); if (u >= NU) return;
    AttnU cu, nu_; decode(u, cu);
    AT_PREFETCH(cu, cu.jb_lo);
    const f32x4 kga = *(const f32x4*)(kgain + 8 * lch), kgb = *(const f32x4*)(kgain + 8 * lch + 4);
    int bsel = 0;
    for (;;) {
        bf16x8 Qf[4];
        { const int t = cu.qrow0 + 16 * wave + i16; const f32x4 pp = *(const f32x4*)(qpart + ((size_t)t * qnh + (cu.qcol >> 7)) * 4);
          const float rq = __builtin_amdgcn_rsqf(((pp[0] + pp[1]) + (pp[2] + pp[3])) * (1.0f / 128.0f) + EPS) * QSCALE2;
#pragma unroll
          for (int ks = 0; ks < 4; ++ks) { const u32x4 raw = *(const u32x4*)(proj + (size_t)t * ldq + cu.qcol + 32 * ks + 8 * g4);
              const f32x4 ga = *(const f32x4*)(qgain + 32 * ks + 8 * g4), gb = *(const f32x4*)(qgain + 32 * ks + 8 * g4 + 4);
              u32x4 w; w.x = pk2(__uint_as_float(raw.x << 16) * rq * ga[0], __uint_as_float(raw.x & 0xffff0000u) * rq * ga[1]);
              w.y = pk2(__uint_as_float(raw.y << 16) * rq * ga[2], __uint_as_float(raw.y & 0xffff0000u) * rq * ga[3]);
              w.z = pk2(__uint_as_float(raw.z << 16) * rq * gb[0], __uint_as_float(raw.z & 0xffff0000u) * rq * gb[1]);
              w.w = pk2(__uint_as_float(raw.w << 16) * rq * gb[2], __uint_as_float(raw.w & 0xffff0000u) * rq * gb[3]);
              Qf[ks] = u4_to_bf8(w); } }
        f32x4 O[8];
#pragma unroll
        for (int d = 0; d < 8; ++d) O[d] = (f32x4){0.f, 0.f, 0.f, 0.f};
        float mrun = cu.m0, lrun = (MODE == 0 && g4 == 0) ? 1.0f : 0.0f;
        const int tq = cu.nq * 128 + 16 * wave + i16;
        const int un = u + G; const bool has_next = un < NU;
        if (has_next) decode(un, nu_);
        for (int jb = cu.jb_lo; jb <= cu.jb_hi; ++jb) {
            LAS unsigned char* ldb = lds + bsel * AT_BUF; bsel ^= 1;
#pragma unroll
            for (int c = 0; c < 4; ++c) { const float rk = __builtin_amdgcn_rsqf(((kpp[c][0] + kpp[c][1]) + (kpp[c][2] + kpp[c][3])) * (1.0f / 128.0f) + EPS);
                const u32x4 raw = kraw[c];
                u32x4 w; w.x = pk2(__uint_as_float(raw.x << 16) * rk * kga[0], __uint_as_float(raw.x & 0xffff0000u) * rk * kga[1]);
                w.y = pk2(__uint_as_float(raw.y << 16) * rk * kga[2], __uint_as_float(raw.y & 0xffff0000u) * rk * kga[3]);
                w.z = pk2(__uint_as_float(raw.z << 16) * rk * kgb[0], __uint_as_float(raw.z & 0xffff0000u) * rk * kgb[1]);
                w.w = pk2(__uint_as_float(raw.w << 16) * rk * kgb[2], __uint_as_float(raw.w & 0xffff0000u) * rk * kgb[3]);
                *(LAS u32x4*)(ldb + (lrow + 32 * c) * AT_KS + lch * 16) = w;
                *(LAS u32x4*)(ldb + AT_VOFF + (lrow + 32 * c) * AT_VS + lch * 16) = vraw[c]; }
            __syncthreads();
            if (jb < cu.jb_hi) { AT_PREFETCH(cu, jb + 1); } else if (has_next) { AT_PREFETCH(nu_, nu_.jb_lo); }
            const unsigned actm = (MODE == 1 || jb == cu.nq) ? 0xffu : (jb < cu.nq ? (0xffu << wave) & 0xffu : (0xffu >> (7 - wave)));
            f32x4 sc[8];
            float mx = -1e30f;
            const float fb = (float)(tq - jb * 128 - 4 * g4);
#pragma unroll
            for (int kt = 0; kt < 8; ++kt) {
                if ((actm >> kt) & 1u) { f32x4 a = (f32x4){0.f, 0.f, 0.f, 0.f};
#pragma unroll
                    for (int ks = 0; ks < 4; ++ks) { const bf16x8 kf = *(const LAS bf16x8*)(ldb + (16 * kt + i16) * AT_KS + (32 * ks + 8 * g4) * 2); a = mfma16(kf, Qf[ks], a); }
#pragma unroll
                    for (int r = 0; r < 4; ++r) { float v = a[r];
                        if (MODE == 0) { const float dist = fabsf(fb - (float)(16 * kt + r)); v = v + cu.nslope2 * dist; v = dist > 128.0f ? -1e30f : v; }
                        a[r] = v; mx = fmaxf(mx, v); }
                    sc[kt] = a; }
                else sc[kt] = (f32x4){-1e30f, -1e30f, -1e30f, -1e30f}; }
            mx = xmax16(mx); mx = xmax32(mx);
            const float mnew = fmaxf(mrun, mx), alpha = fast_exp2(mrun - mnew); mrun = mnew;
            float ls = 0.f;
#pragma unroll
            for (int kt = 0; kt < 8; ++kt) {
                if ((actm >> kt) & 1u) {
#pragma unroll
                    for (int r = 0; r < 4; ++r) { const float pv = fast_exp2(sc[kt][r] - mnew); sc[kt][r] = pv; ls += pv; } }
                else sc[kt] = (f32x4){0.f, 0.f, 0.f, 0.f}; }
            lrun = lrun * alpha + ls;
#pragma unroll
            for (int d = 0; d < 8; ++d) O[d] = O[d] * alpha;
            const LAS unsigned char* vb = ldb + AT_VOFF + (4 * g4 + (i16 >> 2)) * AT_VS + (4 * (i16 & 3)) * 2;
#pragma unroll
            for (int k2 = 0; k2 < 4; ++k2) {
                if ((actm >> (2 * k2)) & 3u) {
                    u32x4 w; w.x = pk2(sc[2 * k2][0], sc[2 * k2][1]); w.y = pk2(sc[2 * k2][2], sc[2 * k2][3]); w.z = pk2(sc[2 * k2 + 1][0], sc[2 * k2 + 1][1]); w.w = pk2(sc[2 * k2 + 1][2], sc[2 * k2 + 1][3]);
                    const bf16x8 pf = u4_to_bf8(w);
#pragma unroll
                    for (int d = 0; d < 8; ++d) { const s16x4 lo = tr_read(vb + (32 * k2) * AT_VS + 32 * d), hi = tr_read(vb + (32 * k2 + 16) * AT_VS + 32 * d);
                        O[d] = mfma16(cat4(lo, hi), pf, O[d]); } } }
        }
        float lt = lrun; lt = xadd16(lt); lt = xadd32(lt);
        const float il = 1.0f / lt;
        bf16_t* orow = cat + (size_t)(cu.qrow0 + 16 * wave + i16) * DM + cu.ocol + 4 * g4;
#pragma unroll
        for (int d = 0; d < 8; ++d) { u32x2 w; w.x = pk2(O[d][0] * il, O[d][1] * il); w.y = pk2(O[d][2] * il, O[d][3] * il); *(u32x2*)(orow + 16 * d) = w; }
        if (!has_next) break;
        u = un; cu = nu_;
    }
#undef AT_PREFETCH
}
__device__ __forceinline__ void phase_attn(const Params& p, int L, bool windowed, LAS unsigned char* lds, int tid, int lane, int wave) {
    if (windowed) { phase_attn_mode<0>(p, L, lds, tid, lane, wave); __syncthreads(); }
    phase_attn_mode<1>(p, L, lds, tid, lane, wave);
    __syncthreads();
}

#define GLD16(ub, lo) (*(const u32x4*)((const char*)(ub) + (lo)))
#define GLD8(ub, lo) (*(const u32x2*)((const char*)(ub) + (lo)))
__device__ __forceinline__ float log2_gamma(float x) { return -log1pf(expf(-x)) * LOG2E; }
constexpr int RT_KS = 288, RT_VS = 544;
__device__ __forceinline__ void phase_ret_kv(const Params& p, int L, LAS unsigned char* lds, int tid, int lane, int wave) {
    const int li = L >> 1; const char* proj = (const char*)(p.ws + WS_PROJ);
    bf16_t* kvc = (bf16_t*)(p.ws + WS_KVC);
    const int i16 = lane & 15, g4 = lane >> 4;
    constexpr int KIMG = 128 * RT_KS, VOFF = 2 * KIMG;
    const unsigned lk = (unsigned)((tid >> 4) * RET_W * 2 + (tid & 15) * 16), lv = (unsigned)((tid >> 5) * RET_W * 2 + (tid & 31) * 16);
    u32x4 kraw[4], vraw[8];
#define RK_PREFETCH(U) do { const int h_ = (U) % 6, n_ = ((U) / 6) & 63, b_ = (U) / 384; const char* pr_ = proj + ((size_t)b_ * SEQ + n_ * 128) * RET_W * 2; \
        _Pragma("unroll") for (int c = 0; c < 4; ++c) kraw[c] = GLD16(pr_ + (size_t)(32 * c) * RET_W * 2 + 1536 + h_ * 256, lk); \
        _Pragma("unroll") for (int c = 0; c < 8; ++c) vraw[c] = GLD16(pr_ + (size_t)(16 * c) * RET_W * 2 + 3072 + h_ * 512, lv); } while (0)
    int u = xcd_vcu(); if (u >= 768) return;
    RK_PREFETCH(u);
    for (;;) {
        const int h = u % 6, n = (u / 6) & 63, b = u / 384;
        const float lgf = log2_gamma(p.in[I_RDF][li * 6 + h]), lgb = log2_gamma(p.in[I_RDB][li * 6 + h]);
        __syncthreads();
#pragma unroll
        for (int c = 0; c < 4; ++c) { const int row = (tid >> 4) + 32 * c; const u32x4 raw = kraw[c];
#pragma unroll
            for (int dir = 0; dir < 2; ++dir) {
                const float z = fast_exp2(dir ? lgb * (float)row : lgf * (float)(127 - row));
                u32x4 w; w.x = pk2(__uint_as_float(raw.x << 16) * z, __uint_as_float(raw.x & 0xffff0000u) * z); w.y = pk2(__uint_as_float(raw.y << 16) * z, __uint_as_float(raw.y & 0xffff0000u) * z);
                w.z = pk2(__uint_as_float(raw.z << 16) * z, __uint_as_float(raw.z & 0xffff0000u) * z); w.w = pk2(__uint_as_float(raw.w << 16) * z, __uint_as_float(raw.w & 0xffff0000u) * z);
                *(LAS u32x4*)(lds + dir * KIMG + row * RT_KS + (tid & 15) * 16) = w; } }
#pragma unroll
        for (int c = 0; c < 8; ++c) *(LAS u32x4*)(lds + VOFF + ((tid >> 5) + 16 * c) * RT_VS + (tid & 31) * 16) = vraw[c];
        __syncthreads();
        const int un = u + (int)gridDim.x; const bool has_next = un < 768;
        if (has_next) RK_PREFETCH(un);
        const LAS unsigned char* vb = lds + VOFF + (4 * g4 + (i16 >> 2)) * RT_VS + (4 * (i16 & 3)) * 2 + 64 * wave;
#pragma unroll 1
        for (int dir = 0; dir < 2; ++dir) {
            f32x4 acc[8][2];
#pragma unroll
            for (int d = 0; d < 8; ++d) { acc[d][0] = (f32x4){0.f, 0.f, 0.f, 0.f}; acc[d][1] = (f32x4){0.f, 0.f, 0.f, 0.f}; }
            const LAS unsigned char* kb = lds + dir * KIMG + (4 * g4 + (i16 >> 2)) * RT_KS + (4 * (i16 & 3)) * 2;
#pragma unroll
            for (int ks = 0; ks < 4; ++ks) {
                bf16x8 bf[2];
#pragma unroll
                for (int et = 0; et < 2; ++et) bf[et] = cat4(tr_read(vb + (32 * ks) * RT_VS + 32 * et), tr_read(vb + (32 * ks + 16) * RT_VS + 32 * et));
#pragma unroll
                for (int d = 0; d < 8; ++d) { const bf16x8 af = cat4(tr_read(kb + (32 * ks) * RT_KS + 32 * d), tr_read(kb + (32 * ks + 16) * RT_KS + 32 * d));
                    acc[d][0] = mfma16(af, bf[0], acc[d][0]); acc[d][1] = mfma16(af, bf[1], acc[d][1]); }
            }
            bf16_t* o = kvc + ((size_t)((dir * 2 + b) * 6 + h) * 64 + n) * 32768;
#pragma unroll
            for (int et = 0; et < 2; ++et)
#pragma unroll
                for (int d = 0; d < 8; ++d) { u32x2 w; w.x = pk2(acc[d][et][0], acc[d][et][1]); w.y = pk2(acc[d][et][2], acc[d][et][3]);
                    *(u32x2*)(o + (size_t)(32 * wave + 16 * et + i16) * 128 + 16 * d + 4 * g4) = w; }
        }
        if (!has_next) break;
        u = un;
    }
    __syncthreads();
#undef RK_PREFETCH
}
__device__ __forceinline__ void phase_ret_scan(const Params& p, int L, int tid) {
    const int li = L >> 1; const bf16_t* kvc = (const bf16_t*)(p.ws + WS_KVC); bf16_t* st = (bf16_t*)(p.ws + WS_ST);
    for (int task = bidx() * 512 + tid; task < 24 * 4096; task += gridDim.x * 512) {
        const int seq = task >> 12, off = (task & 4095) * 8; const int h = seq % 6, dir = seq / 12;
        const float dec = fast_exp2(log2_gamma(dir ? p.in[I_RDB][li * 6 + h] : p.in[I_RDF][li * 6 + h]) * 128.0f);
        const size_t base = (size_t)seq * 64 * 32768 + off;
        float s[8];
#pragma unroll
        for (int j = 0; j < 8; ++j) s[j] = 0.f;
#pragma unroll 1
        for (int q0 = 0; q0 < 64; q0 += 32) {
            u32x4 kv[32];
#pragma unroll
            for (int i = 0; i < 32; ++i) { const int n = dir ? 63 - (q0 + i) : q0 + i; kv[i] = *(const u32x4*)(kvc + base + (size_t)n * 32768); }
#pragma unroll
            for (int i = 0; i < 32; ++i) { const int n = dir ? 63 - (q0 + i) : q0 + i;
                u32x4 w; w.x = pk2(s[0], s[1]); w.y = pk2(s[2], s[3]); w.z = pk2(s[4], s[5]); w.w = pk2(s[6], s[7]);
                *(u32x4*)(st + base + (size_t)n * 32768) = w;
                s[0] = s[0] * dec + __uint_as_float(kv[i].x << 16); s[1] = s[1] * dec + __uint_as_float(kv[i].x & 0xffff0000u);
                s[2] = s[2] * dec + __uint_as_float(kv[i].y << 16); s[3] = s[3] * dec + __uint_as_float(kv[i].y & 0xffff0000u);
                s[4] = s[4] * dec + __uint_as_float(kv[i].z << 16); s[5] = s[5] * dec + __uint_as_float(kv[i].z & 0xffff0000u);
                s[6] = s[6] * dec + __uint_as_float(kv[i].w << 16); s[7] = s[7] * dec + __uint_as_float(kv[i].w & 0xffff0000u); }
        }
    }
}
__device__ __forceinline__ void phase_ret_out(const Params& p, int L, LAS unsigned char* lds, int tid, int lane, int wave) {
    const int li = L >> 1; const char* proj = (const char*)(p.ws + WS_PROJ); const char* st = (const char*)(p.ws + WS_ST);
    char* cat = (char*)(p.ws + WS_CAT);
    const int i16 = lane & 15, g4 = lane >> 4;
    constexpr int QS = 272, KOFF = 128 * QS, VOFF = 2 * 128 * QS, ROFF = VOFF + 128 * RT_VS;
    LAS float* red = (LAS float*)(lds + ROFF);
    u32x4 sq[4], sk[4];
    const unsigned lo = (unsigned)((tid >> 4) * RET_W * 2 + (tid & 15) * 16);
    const unsigned lv = (unsigned)((tid >> 5) * RET_W * 2 + (tid & 31) * 16);
#define RO_PREFETCH(U) do { const int h_ = (U) % 6, n_ = ((U) / 6) & 63, b_ = (U) / 384; const char* pr_ = proj + ((size_t)b_ * SEQ + n_ * 128) * RET_W * 2; \
        _Pragma("unroll") for (int c = 0; c < 4; ++c) { sq[c] = GLD16(pr_ + (size_t)(32 * c) * RET_W * 2 + h_ * 256, lo); sk[c] = GLD16(pr_ + (size_t)(32 * c) * RET_W * 2 + 1536 + h_ * 256, lo); } } while (0)
    int u = bidx(); if (u >= 768) return;
    RO_PREFETCH(u);
    for (;;) {
        const int h = u % 6, n = (u / 6) & 63, b = u / 384;
        const int un = u + (int)gridDim.x; const bool has_next = un < 768;
        const float lgf = log2_gamma(p.in[I_RDF][li * 6 + h]), lgb = log2_gamma(p.in[I_RDB][li * 6 + h]);
        const size_t row0 = (size_t)b * SEQ + n * 128;
        const char* prow = proj + row0 * RET_W * 2;
        const unsigned lst = (unsigned)(i16 * 256 + g4 * 16);
        u32x4 stf[2][4][2];
#define RO_STATE(dir) do { const char* sp = st + (((size_t)(((dir) * 2 + b) * 6 + h) * 64 + n) * 32768 + (size_t)(32 * wave) * 128) * 2; \
        _Pragma("unroll") for (int ks = 0; ks < 4; ++ks) { stf[dir][ks][0] = GLD16(sp + 64 * ks, lst); stf[dir][ks][1] = GLD16(sp + 16 * 256 + 64 * ks, lst); } } while (0)
        RO_STATE(0);
        __syncthreads();
#pragma unroll
        for (int c = 0; c < 4; ++c) {
            *(LAS u32x4*)(lds + ((tid >> 4) + 32 * c) * QS + (tid & 15) * 16) = sq[c];
            *(LAS u32x4*)(lds + KOFF + ((tid >> 4) + 32 * c) * QS + (tid & 15) * 16) = sk[c]; }
        u32x4 sv[8];
#pragma unroll
        for (int c = 0; c < 8; ++c) sv[c] = GLD16(prow + (size_t)(16 * c) * RET_W * 2 + 3072 + h * 512, lv);
        __syncthreads();
        {
            f32x4 sc[8];
            { bf16x8 qf[4];
#pragma unroll
              for (int ks = 0; ks < 4; ++ks) qf[ks] = *(const LAS bf16x8*)(lds + (16 * wave + i16) * QS + (32 * ks + 8 * g4) * 2);
#pragma unroll
              for (int s8 = 0; s8 < 8; ++s8) { f32x4 a = (f32x4){0.f, 0.f, 0.f, 0.f};
#pragma unroll
                  for (int ks = 0; ks < 4; ++ks) { const bf16x8 kf = *(const LAS bf16x8*)(lds + KOFF + (16 * s8 + i16) * QS + (32 * ks + 8 * g4) * 2); a = mfma16(kf, qf[ks], a); }
                  sc[s8] = a; if (s8 & 1) asm volatile("" ::: "memory"); } }
            { int t = 16 * wave + i16 - 4 * g4; asm volatile("" : "+v"(t));
#pragma unroll
              for (int s8 = 0; s8 < 8; ++s8)
#pragma unroll
                  for (int r = 0; r < 4; ++r) { const int dl = t - (16 * s8 + r);
                      const float dcy = dl >= 0 ? fast_exp2(lgf * (float)dl) : fast_exp2(lgb * (float)(-dl)); sc[s8][r] = sc[s8][r] * dcy; } }
#pragma unroll
            for (int c = 0; c < 8; ++c) *(LAS u32x4*)(lds + VOFF + ((tid >> 5) + 16 * c) * RT_VS + (tid & 31) * 16) = sv[c];
            __syncthreads();
#pragma unroll
            for (int s8 = 0; s8 < 8; ++s8) { u32x2 w; w.x = pk2(sc[s8][0], sc[s8][1]); w.y = pk2(sc[s8][2], sc[s8][3]);
                *(LAS u32x2*)(lds + KOFF + (16 * wave + i16) * QS + (16 * s8 + 4 * g4) * 2) = w; }
            __syncthreads();
        }
        RO_STATE(1);
        f32x4 acc[2][8];
#pragma unroll
        for (int et = 0; et < 2; ++et)
#pragma unroll
            for (int tt = 0; tt < 8; ++tt) acc[et][tt] = (f32x4){0.f, 0.f, 0.f, 0.f};
        { const LAS unsigned char* qb = lds + i16 * QS + (8 * g4) * 2;
#pragma unroll
          for (int dir = 0; dir < 2; ++dir) {
#pragma unroll
            for (int ks = 0; ks < 4; ++ks) {
                const bf16x8 a0 = u4_to_bf8(stf[dir][ks][0]), a1 = u4_to_bf8(stf[dir][ks][1]);
#pragma unroll
                for (int tt = 0; tt < 8; ++tt) { const bf16x8 qf = *(const LAS bf16x8*)(qb + (16 * tt) * QS + 64 * ks);
                    acc[0][tt] = mfma16(a0, qf, acc[0][tt]); acc[1][tt] = mfma16(a1, qf, acc[1][tt]); }
                asm volatile("" ::: "memory");
            }
#pragma unroll
            for (int tt = 0; tt < 8; ++tt) { const float t = (float)(16 * tt + i16);
                const float f = dir == 0 ? fast_exp2(lgf * (t + 1.0f) - lgb * (128.0f - t)) : fast_exp2(lgb * (128.0f - t));
                acc[0][tt] = acc[0][tt] * f; acc[1][tt] = acc[1][tt] * f; }
          } }
        if (has_next) RO_PREFETCH(un);
        const unsigned lg = (unsigned)(i16 * RET_W * 2 + g4 * 8);
        u32x2 grv[8][2];
#pragma unroll
        for (int tt = 0; tt < 8; ++tt) { const char* gbase = prow + (size_t)(16 * tt) * RET_W * 2 + (3072 + h * 256 + 32 * wave) * 2;
            grv[tt][0] = GLD8(gbase, lg); grv[tt][1] = GLD8(gbase + 32, lg); }
        { const LAS unsigned char* vb = lds + VOFF + (4 * g4 + (i16 >> 2)) * RT_VS + (4 * (i16 & 3)) * 2 + 64 * wave;
          const LAS unsigned char* pb = lds + KOFF + i16 * QS + (4 * g4) * 2;
#pragma unroll 1
          for (int ks = 0; ks < 4; ++ks) {
              const bf16x8 v0 = cat4(tr_read(vb + (32 * ks) * RT_VS), tr_read(vb + (32 * ks + 16) * RT_VS));
              const bf16x8 v1 = cat4(tr_read(vb + (32 * ks) * RT_VS + 32), tr_read(vb + (32 * ks + 16) * RT_VS + 32));
#pragma unroll
              for (int tt = 0; tt < 8; ++tt) { const LAS unsigned char* pr = pb + (16 * tt) * QS + 64 * ks;
                  const u32x2 plo = *(const LAS u32x2*)pr, phi = *(const LAS u32x2*)(pr + 32);
                  u32x4 pw; pw.x = plo.x; pw.y = plo.y; pw.z = phi.x; pw.w = phi.y; const bf16x8 pf = u4_to_bf8(pw);
                  acc[0][tt] = mfma16(v0, pf, acc[0][tt]); acc[1][tt] = mfma16(v1, pf, acc[1][tt]); }
          } }
        const float kscale = 0.08838834764831845f;
#pragma unroll
        for (int tt = 0; tt < 8; ++tt) { float ss = 0.f;
#pragma unroll
            for (int et = 0; et < 2; ++et) { acc[et][tt] = acc[et][tt] * kscale; ss += (acc[et][tt][0] * acc[et][tt][0] + acc[et][tt][1] * acc[et][tt][1]) + (acc[et][tt][2] * acc[et][tt][2] + acc[et][tt][3] * acc[et][tt][3]); }
            ss = xadd16(ss); ss = xadd32(ss);
            if (g4 == 0) red[wave * 128 + 16 * tt + i16] = ss; }
        __syncthreads();
        const float* og = p.in[I_ROG] + (size_t)li * 1536 + h * 256 + 32 * wave;
        const f32x4 gn0 = *(const f32x4*)(og + 4 * g4), gn1 = *(const f32x4*)(og + 16 + 4 * g4);
        const unsigned lc = (unsigned)(i16 * DM * 2 + g4 * 8);
#pragma unroll
        for (int tt = 0; tt < 8; ++tt) { const int t = 16 * tt + i16; float tot = 0.f;
#pragma unroll
            for (int w = 0; w < 8; ++w) tot += red[w * 128 + t];
            const float rs = 1.0f / sqrtf(tot * (1.0f / 256.0f) + EPS);
            char* cbase = cat + (row0 + 16 * tt) * DM * 2 + (h * 256 + 32 * wave) * 2;
#pragma unroll
            for (int et = 0; et < 2; ++et) {
                const u32x2 gr = grv[tt][et];
                const f32x4 gn = et ? gn1 : gn0;
                const float y0 = acc[et][tt][0] * rs * gn[0] * silu_f(__uint_as_float(gr.x << 16)), y1 = acc[et][tt][1] * rs * gn[1] * silu_f(__uint_as_float(gr.x & 0xffff0000u));
                const float y2 = acc[et][tt][2] * rs * gn[2] * silu_f(__uint_as_float(gr.y << 16)), y3 = acc[et][tt][3] * rs * gn[3] * silu_f(__uint_as_float(gr.y & 0xffff0000u));
                u32x2 w; w.x = pk2(y0, y1); w.y = pk2(y2, y3);
                *(u32x2*)(cbase + 32 * et + lc) = w; } }
        if (!has_next) break;
        u = un;
    }
#undef RO_PREFETCH
#undef RO_STATE
    __syncthreads();
}

constexpr int NPH = 10;
constexpr int N_STEPS = 2 + DEPTH * NPH + 1;
__global__ void __launch_bounds__(512, 2) mega(Params p0) {
    extern __shared__ __attribute__((aligned(16))) unsigned char lds_raw[];
    LAS unsigned char* lds = (LAS unsigned char*)lds_raw;
    const int tid0 = threadIdx.x;
    const int G = gridDim.x; const int ngw = G * 8;
    volatile LAS unsigned* misc = (volatile LAS unsigned*)(lds + LDS_MISC);
    if (tid0 < 4) misc[tid0] = 0u;
    __syncthreads();
    unsigned* ctl = (unsigned*)(p0.ws + WS_CTL);
    XcdBarrier bar = xcd_barrier_post(ctl + 4096 + (size_t)p0.li * XCD_BAR_WORDS, misc);
    const int lo = p0.lo, hi = p0.hi; bool did = false; int L_ = 0;
    const bool defer_moe = (G >= 64) && (DEFER_MOE != 0);
    const bool merge_rt = (G == 256) && (lo == 0) && (hi == N_STEPS) && (MERGE_RT != 0);
    const bool split_cv = defer_moe && (G == 256) && (SPLIT_CV != 0);
#define STEP(k) if (lo <= (k) && (k) < hi && ((did ? (xcd_barrier(bar), 0) : 0), did = true, true))
#define FRESH() int tid = tid0; asm volatile("" : "+v"(tid)); const int lane = tid & 63, wave = __builtin_amdgcn_readfirstlane(tid >> 6); const int gw = bidx() * 8 + wave; const __attribute__((address_space(4))) Params* kp_ = (const __attribute__((address_space(4))) Params*)__builtin_amdgcn_kernarg_segment_ptr(); asm volatile("" : "+s"(kp_)); Params p; _Pragma("unroll") for (int i_ = 0; i_ < 21; ++i_) p.in[i_] = kp_->in[i_]; p.out = kp_->out; p.ws = kp_->ws; p.lo = 0; p.hi = 0; p.li = 0; p.pad = 0; unsigned char* ws = p.ws; (void)lane; (void)gw; (void)ws; int L = L_; asm volatile("" : "+s"(L)); const bool ret = (L & 1) != 0; const int li = L >> 1; (void)ret; (void)li

    STEP(0) { FRESH(); for (int rep_ = 0; rep_ < (DUP_ON(0) ? 2 : 1); ++rep_) { if (rep_) xcd_barrier(bar); if (PH_ON(0)) phase_convert(p, !defer_moe, split_cv ? 1 : 0, lds, gw, ngw, wave, lane); } if (PH_ON(2)) phase_norm1(p, 0, false, true, gw, ngw, lane); }
    STEP(1) if (PH_ON(1)) { FRESH();
        pg8::Gemm g{(const bf16_t*)(ws + WS_MEMN), (const bf16_t*)(ws + WS_WMKV), 2048, 4096, DM, nullptr};
        pg8::EpiProj E{(bf16_t*)(ws + WS_KVM), 4096, (float*)(ws + WS_PARTM), 32, 0x0F0F0F0Full, nullptr};
        if (split_cv) {
            pg8::DiagOrder S{bidx()};
            pg8::gemm_phase<pg8::EpiProj, pg8::DiagOrder, false>(lds, g, S, E);
            if (bidx() >= 32) phase_convert(p, false, 2, lds, (bidx() - 32) * 8 + wave, 224 * 8, wave, lane);
        } else {
            pg8::StaticOrder S; S.init(2048, 4096, G, bidx());
            for (int rep_ = 0; rep_ < (DUP_ON(1) ? 2 : 1); ++rep_) { if (rep_) xcd_barrier(bar); pg8::gemm_phase<pg8::EpiProj, pg8::StaticOrder, false>(lds, g, S, E); }
        }
    }
#pragma unroll 1
    for (int Lo = 0; Lo < NLAYERS; ++Lo) {
        const int base = 2 + Lo * NPH; const bool ret = (Lo & 1) != 0; L_ = Lo;
        if (Lo > 0) { STEP(base + 0) { FRESH(); if (PH_ON(2)) phase_norm1(p, L, true, true, gw, ngw, lane); if (DUP_ON(2)) { xcd_barrier(bar); phase_norm1(p, L, true, true, gw, ngw, lane); } } }
        STEP(base + 1) if (PH_ON(3)) { FRESH();
            const int N = ret ? RET_W : ATT_W;
            pg8::Gemm g{(const bf16_t*)(ws + WS_H), ret ? (const bf16_t*)(ws + WS_WINR) + (size_t)li * RET_W * DM : (const bf16_t*)(ws + WS_WINA) + (size_t)li * ATT_W * DM, TT, N, DM, nullptr};
            pg8::StaticOrder S; S.init(TT, N, G, bidx());
            pg8::EpiProj E{(bf16_t*)(ws + WS_PROJ), N, (float*)(ws + WS_PART), N >> 7, ret ? 0xF000000000ull : 0xF0FFFFull, (const float*)(ws + WS_RS1)};
            for (int rep_ = 0; rep_ < (DUP_ON(3) ? 2 : 1); ++rep_) { if (rep_) xcd_barrier(bar); pg8::gemm_phase<pg8::EpiProj, pg8::StaticOrder, false>(lds, g, S, E); }
        }
        if (!ret) {
            STEP(base + 2) { FRESH(); if (PH_ON(4)) phase_attn(p, L, true, lds, tid, lane, wave); if (DUP_ON(4)) { xcd_barrier(bar); phase_attn(p, L, true, lds, tid, lane, wave); } }
        } else {
            STEP(base + 2) { FRESH(); if (PH_ON(5)) phase_ret_kv(p, L, lds, tid, lane, wave); if (DUP_ON(5)) { xcd_barrier(bar); phase_ret_kv(p, L, lds, tid, lane, wave); } if (PH_ON(14)) phase_attn(p, L, false, lds, tid, lane, wave); if (DUP_ON(14)) { xcd_barrier(bar); phase_attn(p, L, false, lds, tid, lane, wave); } }
            STEP(base + 3) { FRESH(); for (int rep_ = 0; rep_ < (DUP_ON(6) ? 2 : 1); ++rep_) { if (rep_) xcd_barrier(bar); if (PH_ON(6)) phase_ret_scan(p, L, tid); } }
            STEP(base + 4) { FRESH(); for (int rep_ = 0; rep_ < (DUP_ON(7) ? 2 : 1); ++rep_) { if (rep_) xcd_barrier(bar); if (PH_ON(7)) phase_ret_out(p, L, lds, tid, lane, wave); } }
        }
        STEP(base + 5) if (PH_ON(8)) { FRESH();
            pg8::Gemm g{(const bf16_t*)(ws + WS_CAT), (const bf16_t*)(ws + WS_WOUT) + (size_t)L * DM * DM, TT, DM, DM, nullptr};
            pg8::StaticOrder S; S.init(TT, DM, G, bidx());
            pg8::EpiDelta E{(bf16_t*)(ws + WS_XR), DM, (const bf16_t*)(ws + WS_H)};
            for (int rep_ = 0; rep_ < (DUP_ON(8) ? 2 : 1); ++rep_) { if (rep_) xcd_barrier(bar); pg8::gemm_phase<pg8::EpiDelta, pg8::StaticOrder, false>(lds, g, S, E); }
        }
        STEP(base + 6) { FRESH(); for (int rep_ = 0; rep_ < (DUP_ON(9) ? 2 : 1); ++rep_) { if (rep_) xcd_barrier(bar); if (PH_ON(9)) phase_router(p, L, lds, gw, ngw, tid, lane); }
            if (merge_rt) router_publish(ctl + 8192 + (L * 2 + (bidx() >> 7)) * 64); }
        if (merge_rt ? (lo <= base + 6 && base + 6 < hi) : (lo <= base + 7 && base + 7 < hi && ((did ? (xcd_barrier(bar), 0) : 0), did = true, true))) { FRESH();
            if (merge_rt && bidx() < 32) router_wait(ctl + 8192 + (L * 2 + (bidx() >> 4)) * 64, 128u, ctl + 4096 + XB_TMO);
            for (int rep_ = 0; rep_ < (DUP_ON(10) ? 2 : 1); ++rep_) { if (rep_) xcd_barrier(bar); if (PH_ON(10)) phase_topk(p, lds, tid, lane, wave); }
            if (defer_moe) {
                const int nA = (G == 256) ? 2560 : 0, nB = 24576 - nA;
                if (bidx() >= 32) convert_moe_layer(p, L, 0, nB, (bidx() - 32) * 8 + wave, (G - 32) * 8, lds, wave, lane);
                else if (nA) convert_moe_layer(p, L, nB, 24576, bidx() * 8 + wave, 256, lds, wave, lane);
            } }
        STEP(base + 8) if (PH_ON(11)) { FRESH();
            pg8::Gemm g{(const bf16_t*)(ws + WS_XR), (const bf16_t*)(ws + WS_WGU) + (size_t)L * NEXP * 2048 * DM, NSLOT, 2048, DM, (const int*)(ws + WS_ROWIDX)};
            pg8::MoeOrder S{G, bidx()};
            pg8::EpiSwiglu E{(bf16_t*)(ws + WS_HID), (const float*)(ws + WS_RSLOT)};
            for (int rep_ = 0; rep_ < (DUP_ON(11) ? 2 : 1); ++rep_) { if (rep_) xcd_barrier(bar); pg8::gemm_phase<pg8::EpiSwiglu, pg8::MoeOrder, true, MOE_B_AUX>(lds, g, S, E); }
        }
        STEP(base + 9) if (PH_ON(12)) { FRESH();
            pg8::Gemm g{(const bf16_t*)(ws + WS_HID), (const bf16_t*)(ws + WS_WDN) + (size_t)L * NEXP * DM * FF, NSLOT, DM, FF, nullptr};
            pg8::MoeOrder S{G, bidx()};
            pg8::EpiDown E{(bf16_t*)(ws + WS_Y), (const float*)(ws + WS_GATEV)};
            for (int rep_ = 0; rep_ < (DUP_ON(12) ? 2 : 1); ++rep_) { if (rep_) xcd_barrier(bar); pg8::gemm_phase<pg8::EpiDown, pg8::MoeOrder, false, MOE_B_AUX>(lds, g, S, E); }
        }
    }
    if (DUP_ON(20) && hi > 5) { for (int i_ = 0; i_ < 40; ++i_) xcd_barrier(bar); }
    L_ = 0;
    STEP(2 + DEPTH * NPH) { FRESH(); if (PH_ON(13)) phase_norm1(p, 0, true, false, gw, ngw, lane); }
#undef STEP
}

extern "C" void kernel_launch(void* const* d_in, const int* in_sizes, int n_in, void* d_out, int out_size, void* d_ws, size_t ws_size, hipStream_t stream) {
    static int grid = 0;
    if (grid == 0) {
        if (n_in != 21 || out_size != TT * DM || ws_size < WS_END) { fprintf(stderr, "kernel_launch: unexpected shapes (n_in %d out %d ws %zu)\n", n_in, out_size, ws_size); grid = -1; return; }
        int dev = 0, cus = 0, per_cu = 0;
        if (hipGetDevice(&dev) != hipSuccess || hipDeviceGetAttribute(&cus, hipDeviceAttributeMultiprocessorCount, dev) != hipSuccess) { grid = -1; return; }
        if (hipFuncSetAttribute((const void*)mega, hipFuncAttributeMaxDynamicSharedMemorySize, LDS_BYTES) != hipSuccess) { fprintf(stderr, "kernel_launch: hipFuncSetAttribute failed\n"); grid = -1; return; }
        if (hipOccupancyMaxActiveBlocksPerMultiprocessor(&per_cu, (const void*)mega, 512, LDS_BYTES) != hipSuccess || per_cu < 1) fprintf(stderr, "kernel_launch: occupancy query says %d\n", per_cu);
        (void)hipGetLastError();
        grid = cus;
    }
    if (grid < 0) return;
    (void)hipMemsetAsync((char*)d_ws + WS_CTL, 0, MK_FUSED ? (size_t)65536 : CTL_BYTES, stream);
    Params a{};
    for (int i = 0; i < 21; ++i) a.in[i] = (const float*)d_in[i];
    a.out = (float*)d_out; a.ws = (unsigned char*)d_ws; a.pad = 0;
#if MK_FUSED
    a.lo = 0; a.hi = N_STEPS; a.li = 0;
    hipLaunchKernelGGL(mega, dim3(grid), dim3(512), LDS_BYTES, stream, a);
#else
    int li = 0;
    for (int s = 0; s < N_STEPS; ++s) {
        if (s >= 2 && s < 2 + DEPTH * NPH) { const int L = (s - 2) / NPH, ph = (s - 2) % NPH; if ((L & 1) == 0 && (ph == 3 || ph == 4)) continue; }
        a.lo = s; a.hi = s + 1; a.li = li++;
        hipLaunchKernelGGL(mega, dim3(grid), dim3(512), LDS_BYTES, stream, a);
    }
#endif
}
```
